# Optimizing an MI355X kernel written in HIP

```python
import jax, jax.numpy as jnp
from jax import lax
import numpy as np

D_MODEL = 1024
BATCH = 4
SEQ = 8192
DEPTH = 2

MEM_LEN = 256
D_FF = 2816
N_EVEN = (DEPTH + 1) // 2
N_ODD = DEPTH // 2

CONV_A_CH = 512
CONV_A_WIDTH = 31
SWA_HEADS = 8
SWA_KV_HEADS = 2
SWA_GROUP = SWA_HEADS // SWA_KV_HEADS
HEAD_DIM = 64
WINDOW = 128
BLOCK = 128
EVEN_IN = 2 * CONV_A_CH + (SWA_HEADS + 2 * SWA_KV_HEADS) * HEAD_DIM
EVEN_MIX = CONV_A_CH + SWA_HEADS * HEAD_DIM
SC_CH = 1024
SC_WIDTH = 3
XA_HEADS = 4
XA_HEAD_DIM = D_MODEL // XA_HEADS

RMS_EPS = 1e-6
LN_EPS = 1e-5

kernel_name = "hybrid_conformer_swa_shortconv_macaron"


def rmsnorm(x, g):
    x32 = x.astype(jnp.float32)
    y = x32 * lax.rsqrt(jnp.mean(x32 * x32, axis=-1, keepdims=True) + RMS_EPS)
    return y.astype(x.dtype) * g


def layernorm(x, g, b):
    x32 = x.astype(jnp.float32)
    mu = jnp.mean(x32, axis=-1, keepdims=True)
    var = jnp.mean(jnp.square(x32 - mu), axis=-1, keepdims=True)
    y = (x32 - mu) * lax.rsqrt(var + LN_EPS)
    return y.astype(x.dtype) * g + b


def swiglu(u, w_gu, w_down):
    gu = u @ w_gu
    return (jax.nn.silu(gu[..., :D_FF]) * gu[..., D_FF:]) @ w_down


def causal_depthwise_conv(x, w):
    k_width, ch = w.shape
    return lax.conv_general_dilated(
        x, w[:, None, :].astype(x.dtype), window_strides=(1,), padding=[(k_width - 1, 0)],
        dimension_numbers=("NWC", "WIO", "NWC"), feature_group_count=ch)


def alibi_slopes(n_heads):
    return 2.0 ** (-8.0 * jnp.arange(1, n_heads + 1, dtype=jnp.float32) / n_heads)


def conformer_conv(a_val, a_gate, conv_w, conv_b, ln_g, ln_b):
    a = a_val * jax.nn.sigmoid(a_gate)
    a = causal_depthwise_conv(a, conv_w) + conv_b
    return jax.nn.silu(layernorm(a, ln_g, ln_b))


def sliding_window_gqa(q, k, v, sinks):
    bsz, seq = q.shape[:2]
    nb = seq // BLOCK
    qb = q.reshape(bsz, nb, BLOCK, SWA_KV_HEADS, SWA_GROUP, HEAD_DIM)
    kb = k.reshape(bsz, nb, BLOCK, SWA_KV_HEADS, HEAD_DIM)
    vb = v.reshape(bsz, nb, BLOCK, SWA_KV_HEADS, HEAD_DIM)
    pad = ((0, 0), (1, 0), (0, 0), (0, 0), (0, 0))
    kk = jnp.concatenate([jnp.pad(kb, pad)[:, :-1], kb], axis=2)
    vv = jnp.concatenate([jnp.pad(vb, pad)[:, :-1], vb], axis=2)
    scores = jnp.einsum("bnqkgd,bnskd->bnkgqs", qb, kk).astype(jnp.float32) * (HEAD_DIM ** -0.5)
    dist = jnp.arange(BLOCK)[:, None] + BLOCK - jnp.arange(2 * BLOCK)[None, :]
    key_pos = jnp.arange(nb)[:, None] * BLOCK - BLOCK + jnp.arange(2 * BLOCK)[None, :]
    valid = ((dist >= 0) & (dist < WINDOW))[None] & (key_pos >= 0)[:, None, :]
    slopes = alibi_slopes(SWA_HEADS).reshape(SWA_KV_HEADS, SWA_GROUP)
    scores = scores - slopes[:, :, None, None] * dist.astype(jnp.float32)
    scores = jnp.where(valid[None, :, None, None], scores, -jnp.inf)
    sink = jnp.broadcast_to(
        sinks.astype(jnp.float32).reshape(SWA_KV_HEADS, SWA_GROUP)[None, None, :, :, None, None],
        scores.shape[:-1] + (1,))
    probs = jax.nn.softmax(jnp.concatenate([scores, sink], axis=-1), axis=-1)[..., :-1]
    out = jnp.einsum("bnkgqs,bnskd->bnqkgd", probs.astype(vv.dtype), vv)
    return out.reshape(bsz, seq, SWA_HEADS * HEAD_DIM)


def even_mixer(u, w_in, conv_w, conv_b, ln_g, ln_b, sinks, w_out):
    bsz, seq, _ = u.shape
    z = u @ w_in
    o0 = CONV_A_CH
    o1 = o0 + CONV_A_CH
    o2 = o1 + SWA_HEADS * HEAD_DIM
    o3 = o2 + SWA_KV_HEADS * HEAD_DIM
    a = conformer_conv(z[..., :o0], z[..., o0:o1], conv_w, conv_b, ln_g, ln_b)
    q = z[..., o1:o2].reshape(bsz, seq, SWA_KV_HEADS, SWA_GROUP, HEAD_DIM)
    k = z[..., o2:o3].reshape(bsz, seq, SWA_KV_HEADS, HEAD_DIM)
    v = z[..., o3:].reshape(bsz, seq, SWA_KV_HEADS, HEAD_DIM)
    o = sliding_window_gqa(q, k, v, sinks)
    return jnp.concatenate([a, o], axis=-1) @ w_out


def odd_mixer(u, w_in, conv_w, w_out):
    z = u @ w_in
    gate_b = z[..., :SC_CH]
    gate_c = z[..., SC_CH:2 * SC_CH]
    val = z[..., 2 * SC_CH:]
    y = gate_b * causal_depthwise_conv(gate_c * val, conv_w)
    return y @ w_out


def memory_cross_attention(u, m, wq, wkv, wo):
    bsz, seq, _ = u.shape
    mlen = m.shape[1]
    q = (u @ wq).reshape(bsz, seq, XA_HEADS, XA_HEAD_DIM)
    kv = m @ wkv
    k = kv[..., :D_MODEL].reshape(bsz, mlen, XA_HEADS, XA_HEAD_DIM)
    v = kv[..., D_MODEL:].reshape(bsz, mlen, XA_HEADS, XA_HEAD_DIM)
    s = jnp.einsum("bqhd,bkhd->bhqk", q, k).astype(jnp.float32) * (XA_HEAD_DIM ** -0.5)
    p = jax.nn.softmax(s, axis=-1).astype(v.dtype)
    o = jnp.einsum("bhqk,bkhd->bqhd", p, v).reshape(bsz, seq, D_MODEL)
    return o @ wo


def _normal(key, shape, fan_in):
    return jax.random.normal(key, shape, jnp.float32) * (fan_in ** -0.5)


def _gain(key, shape):
    return 1.0 + 0.05 * jax.random.normal(key, shape, jnp.float32)


def setup_inputs(seed: int = 0) -> dict:
    key = jax.random.key(seed)
    ks = jax.random.split(key, 32)
    D, F = D_MODEL, D_FF
    return {
        "x": jax.random.normal(ks[0], (BATCH, SEQ, D), jnp.float32),
        "mem": jax.random.normal(ks[1], (BATCH, MEM_LEN, D), jnp.float32),
        "ffn1_norm": _gain(ks[2], (DEPTH, D)),
        "ffn1_w_gu": _normal(ks[3], (DEPTH, D, 2 * F), D),
        "ffn1_w_down": _normal(ks[4], (DEPTH, F, D), F),
        "mix_norm": _gain(ks[5], (DEPTH, D)),
        "even_w_in": _normal(ks[6], (N_EVEN, D, EVEN_IN), D),
        "conv_a_w": _normal(ks[7], (N_EVEN, CONV_A_WIDTH, CONV_A_CH), CONV_A_WIDTH),
        "conv_a_b": 0.02 * jax.random.normal(ks[8], (N_EVEN, CONV_A_CH), jnp.float32),
        "conv_a_ln_g": _gain(ks[9], (N_EVEN, CONV_A_CH)),
        "conv_a_ln_b": 0.02 * jax.random.normal(ks[10], (N_EVEN, CONV_A_CH), jnp.float32),
        "swa_sinks": 0.5 * jax.random.normal(ks[11], (N_EVEN, SWA_HEADS), jnp.float32),
        "even_w_out": _normal(ks[12], (N_EVEN, EVEN_MIX, D), EVEN_MIX),
        "odd_w_in": _normal(ks[13], (N_ODD, D, 3 * SC_CH), D),
        "sc_conv_w": _normal(ks[14], (N_ODD, SC_WIDTH, SC_CH), SC_WIDTH),
        "odd_w_out": _normal(ks[15], (N_ODD, SC_CH, D), SC_CH),
        "xa_norm": _gain(ks[16], (DEPTH, D)),
        "xa_mem_norm": _gain(ks[17], (DEPTH, D)),
        "xa_wq": _normal(ks[18], (DEPTH, D, D), D),
        "xa_wkv": _normal(ks[19], (DEPTH, D, 2 * D), D),
        "xa_wo": _normal(ks[20], (DEPTH, D, D), D),
        "ffn2_norm": _gain(ks[21], (DEPTH, D)),
        "ffn2_w_gu": _normal(ks[22], (DEPTH, D, 2 * F), D),
        "ffn2_w_down": _normal(ks[23], (DEPTH, F, D), F),
        "final_norm": _gain(ks[24], (D,)),
    }


def reference(x, mem, ffn1_norm, ffn1_w_gu, ffn1_w_down, mix_norm, even_w_in, conv_a_w, conv_a_b,
              conv_a_ln_g, conv_a_ln_b, swa_sinks, even_w_out, odd_w_in, sc_conv_w, odd_w_out,
              xa_norm, xa_mem_norm, xa_wq, xa_wkv, xa_wo, ffn2_norm, ffn2_w_gu, ffn2_w_down, final_norm):
    h = x
    for i in range(DEPTH):
        h = h + 0.5 * swiglu(rmsnorm(h, ffn1_norm[i]), ffn1_w_gu[i], ffn1_w_down[i])
        u = rmsnorm(h, mix_norm[i])
        j = i // 2
        if i % 2 == 0:
            h = h + even_mixer(u, even_w_in[j], conv_a_w[j], conv_a_b[j], conv_a_ln_g[j],
                               conv_a_ln_b[j], swa_sinks[j], even_w_out[j])
        else:
            h = h + odd_mixer(u, odd_w_in[j], sc_conv_w[j], odd_w_out[j])
        h = h + memory_cross_attention(rmsnorm(h, xa_norm[i]), rmsnorm(mem, xa_mem_norm[i]),
                                       xa_wq[i], xa_wkv[i], xa_wo[i])
        h = h + 0.5 * swiglu(rmsnorm(h, ffn2_norm[i]), ffn2_w_gu[i], ffn2_w_down[i])
    return rmsnorm(h, final_norm)
```

```cpp
#include <hip/hip_runtime.h>
#include <hip/hip_cooperative_groups.h>
#include <cstdio>
#include <cstdint>
namespace cg = cooperative_groups;

#define LAS __attribute__((address_space(3)))
typedef unsigned short bf16_t;
typedef short bf16x8 __attribute__((ext_vector_type(8)));
typedef float f32x4 __attribute__((ext_vector_type(4)));
typedef float f32x2 __attribute__((ext_vector_type(2)));
typedef float f32x16 __attribute__((ext_vector_type(16)));
typedef unsigned u32x4 __attribute__((ext_vector_type(4)));
typedef unsigned u32x2 __attribute__((ext_vector_type(2)));
typedef __bf16 bf2_t __attribute__((ext_vector_type(2)));

constexpr int M = 32768, D = 1024, F = 2816, SEQ = 8192, NB = 4;
constexpr int EIN = 1792, OIN = 3072;
constexpr int ZE_LD = 1280, ZO_LD = 2048;
constexpr float RMS_EPS = 1e-6f, LN_EPS = 1e-5f;
constexpr int NTHREADS = 512, NWAVES = 8;
constexpr int LDS_BYTES = 147456;
constexpr int BARST_OFF = 139264;
constexpr int EXCH_OFF = 131072;

constexpr size_t MiB = 1u << 20;
constexpr size_t WS_SS = 464 * MiB;
constexpr size_t WS_BAR = 1280 * 1024;
constexpr size_t WS_CEN = 1536 * 1024;
constexpr size_t WS_PCNT = WS_CEN + 4096;
constexpr size_t WS_WGU = 2 * MiB;
constexpr size_t WS_WDN = 46 * MiB;
constexpr size_t WS_WEIN = 68 * MiB;
constexpr size_t WS_WEOUT = 72 * MiB;
constexpr size_t WS_WOIN = 74 * MiB;
constexpr size_t WS_WOOUT = 80 * MiB;
constexpr size_t WS_WQ = 82 * MiB;
constexpr size_t WS_WKV = 86 * MiB;
constexpr size_t WS_WOT = 94 * MiB;
constexpr size_t WS_MEMN = 98 * MiB;
constexpr size_t WS_KV = 102 * MiB;
constexpr size_t WS_WST = 110 * MiB;
constexpr size_t WS_WVOT = 126 * MiB;
constexpr size_t WS_HB = 144 * MiB;
constexpr size_t WS_MIX = 208 * MiB;
constexpr size_t WS_ZH = 272 * MiB;
constexpr size_t WS_HB8 = 468 * MiB;
constexpr size_t WS_END = 500 * MiB;

__device__ __forceinline__ unsigned pk(float a, float b) { f32x2 v = {a, b}; bf2_t r = __builtin_convertvector(v, bf2_t); return __builtin_bit_cast(unsigned, r); }
__device__ __forceinline__ float bflo(unsigned u) { return __builtin_bit_cast(float, u << 16); }
__device__ __forceinline__ float bfhi(unsigned u) { return __builtin_bit_cast(float, u & 0xffff0000u); }
__device__ __forceinline__ float wave_sum(float v) {
#pragma unroll
    for (int o = 1; o < 64; o <<= 1) v += __shfl_xor(v, o);
    return v;
}
__device__ __forceinline__ int opaque_tid(int wv) { unsigned z = 0u; asm volatile("" : "+v"(z)); int t = (wv << 6) | (int)__builtin_amdgcn_mbcnt_hi(~0u, __builtin_amdgcn_mbcnt_lo(~0u, z)); asm volatile("" : "+v"(t)); return t; }
typedef long l64x2 __attribute__((ext_vector_type(2)));
__device__ __forceinline__ u32x2 pk8(f32x4 a, f32x4 b) {
    int w0 = __builtin_amdgcn_cvt_pk_fp8_f32(a[0], a[1], 0, false); w0 = __builtin_amdgcn_cvt_pk_fp8_f32(a[2], a[3], w0, true);
    int w1 = __builtin_amdgcn_cvt_pk_fp8_f32(b[0], b[1], 0, false); w1 = __builtin_amdgcn_cvt_pk_fp8_f32(b[2], b[3], w1, true);
    return (u32x2){(unsigned)w0, (unsigned)w1}; }
typedef unsigned long long u64_t;
typedef unsigned ss_t;
__device__ __forceinline__ float ssval(const ss_t* ss, int row) { return (float)ss[row] * (1.0f / 256.0f); }
__device__ __forceinline__ ss_t ssfix(float sq) { return (ss_t)(sq * 256.0f + 0.5f); }
__device__ __forceinline__ float sigmoidf_(float x) { return __builtin_amdgcn_rcpf(1.0f + __expf(-x)); }

namespace pg8 {
constexpr int BM = 256, BK = 64, HALF = 128, HTB = HALF * BK * 2, STAGE_BYTES = 8 * HTB, NXCD = 8, WGM = 8;
__device__ __forceinline__ int lds_byte(int r, int c) { const int st = (r >> 4) * 2 + (c >> 5), rr = r & 15, cc = c & 31, ob = rr * 64 + cc * 2; return st * 1024 + (ob ^ (((ob >> 9) & 1) << 5)); }
__device__ __forceinline__ void stage_rc(int b, int& R, int& C) { const int st = b / 1024, sb = b % 1024, swz = sb ^ (((sb >> 9) & 1) << 5); R = (st >> 1) * 16 + swz / 64; C = (st & 1) * 32 + (swz % 64) / 2; }
__device__ __forceinline__ int perm32(int rho) { const int n = rho >> 4, i = rho & 15; return 8 * (i >> 2) + 4 * n + (i & 3); }

struct Unit { int pm, pn; unsigned aoff, boff; };
struct Gemm { const bf16_t* A; const bf16_t* Bt; int lda, ldb, K; };

struct StdOrder {
    int nM, nN, nwg, G, c; unsigned arow, brow, bbatch; int bshift;
    __device__ void init(int Mr, int Nr, int G_, int c_, int lda, int ldb, int bshift_ = 0, unsigned bbatch_rows = 0) {
        nM = Mr / BM; nN = Nr / BM; nwg = nM * nN; G = G_; c = c_; arow = (unsigned)(BM * lda * 2); brow = (unsigned)(BM * ldb * 2); bshift = bshift_; bbatch = bbatch_rows * (unsigned)(ldb * 2); }
    __device__ bool next(int i, Unit& u) const {
        const int L = i * G + c; if (L >= nwg) return false;
        int wgid = L; { const int q = nwg / NXCD, r = nwg % NXCD, xcd = wgid % NXCD, off = wgid / NXCD; wgid = (xcd < r ? xcd * (q + 1) : r * (q + 1) + (xcd - r) * q) + off; }
        const int nig = WGM * nN, gid = wgid / nig, fm = gid * WGM, gsz = (nM - fm) < WGM ? (nM - fm) : WGM;
        u.pm = fm + ((wgid % nig) % gsz); u.pn = (wgid % nig) / gsz;
        u.aoff = (unsigned)u.pm * arow; u.boff = (unsigned)u.pn * brow + (unsigned)(u.pm >> bshift) * bbatch; return true;
    }
};
struct FoldSOrder {
    int G, c;
    __device__ bool next(int i, Unit& u) const {
        const int idx = i * G + c; if (idx >= 128) return false;
        const int l = idx >> 6, r = idx & 63, bh = r >> 2, pn = r & 3, b = bh >> 2, h = bh & 3;
        u.pm = l * 16 + bh; u.pn = pn;
        u.aoff = (unsigned)(((l * 1024 + b * 256) * 2048 + h * 256) * 2);
        u.boff = (unsigned)(((l * 1024 + pn * 256) * 1024 + h * 256) * 2); return true;
    }
};
struct FoldVOrder {
    int G, c;
    __device__ bool next(int i, Unit& u) const {
        const int idx = i * G + c; if (idx >= 128) return false;
        const int l = idx >> 6, r = idx & 63, pmo = r & 3, bh = r >> 2, b = bh >> 2, h = bh & 3;
        u.pm = (l * 4 + b) * 4 + pmo; u.pn = h;
        u.aoff = (unsigned)(((l * 1024 + pmo * 256) * 1024 + h * 256) * 2);
        u.boff = (unsigned)(((l * 1024 + b * 256) * 2048 + 1024 + h * 256) * 2); return true;
    }
};

template <bool RS> struct EpiBf16 {
    static constexpr bool PRE = false;
    bf16_t* O; int ldc; const ss_t* ss; float cs;
    __device__ __forceinline__ void operator()(f32x4 (&acc)[2][2][4][2], const Unit& u, int wr, int wc, int fr, int fq, LAS unsigned char*) const {
        const int row0 = u.pm * BM + wr * 64 + fr, col0 = u.pn * BM + wc * 32 + 8 * fq;
        float rr[2][4];
#pragma unroll
        for (int ai = 0; ai < 2; ++ai)
#pragma unroll
            for (int m = 0; m < 4; ++m) rr[ai][m] = RS ? ssval(ss, row0 + ai * HALF + m * 16) : 0.f;
#pragma unroll
        for (int ai = 0; ai < 2; ++ai)
#pragma unroll
            for (int m = 0; m < 4; ++m) {
                const int row = row0 + ai * HALF + m * 16;
                float r = cs; if (RS) r *= __builtin_amdgcn_rsqf(rr[ai][m] * (1.0f / D) + RMS_EPS);
                bf16_t* rowp = O + (size_t)row * ldc + col0;
#pragma unroll
                for (int bj = 0; bj < 2; ++bj) { const f32x4 v0 = acc[ai][bj][m][0] * r, v1 = acc[ai][bj][m][1] * r;
                    u32x4 w; w.x = pk(v0[0], v0[1]); w.y = pk(v0[2], v0[3]); w.z = pk(v1[0], v1[1]); w.w = pk(v1[2], v1[3]);
                    *(u32x4*)(rowp + bj * HALF) = w; }
            }
    }
};
template <int ODD> struct EpiGate {
    static constexpr bool PRE = true;
    bf16_t* O; int ldc; const ss_t* ss;
    __device__ __forceinline__ void operator()(f32x4 (&acc)[2][2][4][2], const Unit& u, int wr, int wc, int fr, int fq, LAS unsigned char* ex) const {
        const int row0 = u.pm * BM + wr * 64 + fr;
        const LAS unsigned* rs_lds = (const LAS unsigned*)(ex + (wr * 4 + wc) * 512);
        const bool gated = ODD ? (u.pn >= 4) : (u.pn < 4);
        const int gcol = (ODD ? 1024 + (u.pn - 4) * HALF : u.pn * HALF) + wc * 32 + 8 * fq;
        const int pcol = (ODD ? u.pn * BM : 512 + (u.pn - 4) * BM) + wc * 32 + 8 * fq;
        float rr[2][4];
#pragma unroll
        for (int ai = 0; ai < 2; ++ai)
#pragma unroll
            for (int m = 0; m < 4; ++m) rr[ai][m] = (float)rs_lds[ai * 64 + m * 16 + fr] * (1.0f / 256.0f);
        if (gated) {
#pragma unroll
            for (int ai = 0; ai < 2; ++ai)
#pragma unroll
                for (int m = 0; m < 4; ++m) {
                    const int row = row0 + ai * HALF + m * 16;
                    const float r = __builtin_amdgcn_rsqf(rr[ai][m] * (1.0f / D) + RMS_EPS);
                    float h[8];
#pragma unroll
                    for (int n = 0; n < 2; ++n)
#pragma unroll
                        for (int e = 0; e < 4; ++e) { const float x0 = acc[ai][0][m][n][e] * r, x1 = acc[ai][1][m][n][e] * r; h[n * 4 + e] = ODD ? x0 * x1 : x0 * sigmoidf_(x1); }
                    u32x4 w; w.x = pk(h[0], h[1]); w.y = pk(h[2], h[3]); w.z = pk(h[4], h[5]); w.w = pk(h[6], h[7]);
                    *(u32x4*)(O + (size_t)row * ldc + gcol) = w;
                }
        } else {
#pragma unroll
            for (int ai = 0; ai < 2; ++ai)
#pragma unroll
                for (int m = 0; m < 4; ++m) {
                    const int row = row0 + ai * HALF + m * 16;
                    const float r = __builtin_amdgcn_rsqf(rr[ai][m] * (1.0f / D) + RMS_EPS);
                    bf16_t* rowp = O + (size_t)row * ldc + pcol;
#pragma unroll
                    for (int bj = 0; bj < 2; ++bj) { const f32x4 v0 = acc[ai][bj][m][0] * r, v1 = acc[ai][bj][m][1] * r;
                        u32x4 w; w.x = pk(v0[0], v0[1]); w.y = pk(v0[2], v0[3]); w.z = pk(v1[0], v1[1]); w.w = pk(v1[2], v1[3]);
                        *(u32x4*)(rowp + bj * HALF) = w; }
                }
        }
    }
};
struct EpiFp8 {
    static constexpr bool PRE = false;
    unsigned char* O; int ldc; float cs;
    __device__ __forceinline__ void operator()(f32x4 (&acc)[2][2][4][2], const Unit& u, int wr, int wc, int fr, int fq, LAS unsigned char*) const {
        const int row0 = u.pm * BM + wr * 64 + fr, col0 = u.pn * BM + wc * 32 + 8 * fq;
#pragma unroll
        for (int ai = 0; ai < 2; ++ai)
#pragma unroll
            for (int m = 0; m < 4; ++m) { unsigned char* rowp = O + (size_t)(row0 + ai * HALF + m * 16) * ldc + col0;
#pragma unroll
                for (int bj = 0; bj < 2; ++bj) *(u32x2*)(rowp + bj * HALF) = pk8(acc[ai][bj][m][0] * cs, acc[ai][bj][m][1] * cs); }
    }
};
struct EpiNull {
    static constexpr bool PRE = false;
    __device__ __forceinline__ void operator()(f32x4 (&acc)[2][2][4][2], const Unit&, int, int, int, int, LAS unsigned char*) const {
#pragma unroll
        for (int ai = 0; ai < 2; ++ai)
#pragma unroll
            for (int bj = 0; bj < 2; ++bj)
#pragma unroll
                for (int m = 0; m < 4; ++m)
#pragma unroll
                    for (int n = 0; n < 2; ++n) asm volatile("" :: "v"(acc[ai][bj][m][n]));
    }
};
struct EpiSwiGLU {
    static constexpr bool PRE = true;
    bf16_t* O; const ss_t* ss;
    __device__ __forceinline__ void operator()(f32x4 (&acc)[2][2][4][2], const Unit& u, int wr, int wc, int fr, int fq, LAS unsigned char* ex) const {
        const int row0 = u.pm * BM + wr * 64 + fr, col0 = u.pn * HALF + wc * 32 + 8 * fq;
        const LAS unsigned* rs_lds = (const LAS unsigned*)(ex + (wr * 4 + wc) * 512);
#pragma unroll
        for (int ai = 0; ai < 2; ++ai)
#pragma unroll
            for (int m = 0; m < 4; ++m) {
                const int row = row0 + ai * HALF + m * 16;
                const float ir2 = (float)rs_lds[ai * 64 + m * 16 + fr] * (1.0f / (256.0f * D)) + RMS_EPS, r = __builtin_amdgcn_rsqf(ir2);
                const float c1 = -1.44269504089f * r;
                float h[8];
#pragma unroll
                for (int n = 0; n < 2; ++n)
#pragma unroll
                    for (int e = 0; e < 4; e += 2) {
                        const f32x2 g2 = (f32x2){acc[ai][0][m][n][e], acc[ai][0][m][n][e + 1]}, u2 = (f32x2){acc[ai][1][m][n][e], acc[ai][1][m][n][e + 1]};
                        const f32x2 t2 = g2 * c1; f32x2 d2; d2.x = __builtin_amdgcn_exp2f(t2.x); d2.y = __builtin_amdgcn_exp2f(t2.y); d2 = d2 * ir2 + ir2;
                        f32x2 q2; q2.x = __builtin_amdgcn_rcpf(d2.x); q2.y = __builtin_amdgcn_rcpf(d2.y);
                        const f32x2 y2 = (g2 * u2) * q2; h[n * 4 + e] = y2.x; h[n * 4 + e + 1] = y2.y; }
                u32x4 w; w.x = pk(h[0], h[1]); w.y = pk(h[2], h[3]); w.z = pk(h[4], h[5]); w.w = pk(h[6], h[7]);
                *(u32x4*)(O + (size_t)row * F + col0) = w;
            }
    }
};
template <bool BASE_F32, bool W8 = false> struct EpiRes {
    static constexpr bool PRE = false;
    const float* basef; bf16_t* hb; ss_t* ss_out; float scale; unsigned char* hb8;
    __device__ __forceinline__ void operator()(f32x4 (&acc)[2][2][4][2], const Unit& u, int wr, int wc, int fr, int fq, LAS unsigned char*) const {
        const int row0 = u.pm * BM + wr * 64 + fr, col0 = u.pn * BM + wc * 32 + 8 * fq;
        if constexpr (!BASE_F32 && !W8) {
            u32x4 bw[2][4][2];
#pragma unroll
            for (int ai = 0; ai < 2; ++ai)
#pragma unroll
                for (int m = 0; m < 4; ++m)
#pragma unroll
                    for (int bj = 0; bj < 2; ++bj) bw[ai][m][bj] = __builtin_nontemporal_load((const u32x4*)(hb + (size_t)(row0 + ai * HALF + m * 16) * D + col0 + bj * HALF));
#pragma unroll
            for (int ai = 0; ai < 2; ++ai)
#pragma unroll
                for (int m = 0; m < 4; ++m) {
                    const int row = row0 + ai * HALF + m * 16; const size_t off = (size_t)row * D + col0; float sq = 0.f;
#pragma unroll
                    for (int bj = 0; bj < 2; ++bj) {
                        const u32x4 wb = bw[ai][m][bj];
                        const f32x4 b0 = (f32x4){bflo(wb.x), bfhi(wb.x), bflo(wb.y), bfhi(wb.y)}, b1 = (f32x4){bflo(wb.z), bfhi(wb.z), bflo(wb.w), bfhi(wb.w)};
                        const f32x4 h0 = b0 + acc[ai][bj][m][0] * scale, h1 = b1 + acc[ai][bj][m][1] * scale;
                        u32x4 w; w.x = pk(h0[0], h0[1]); w.y = pk(h0[2], h0[3]); w.z = pk(h1[0], h1[1]); w.w = pk(h1[2], h1[3]);
                        *(u32x4*)(hb + off + bj * HALF) = w;
#pragma unroll
                        for (int e = 0; e < 4; ++e) { const float x0 = bflo(w[e]), x1 = bfhi(w[e]); sq += x0 * x0 + x1 * x1; }
                    }
                    sq += __shfl_xor(sq, 16); sq += __shfl_xor(sq, 32);
                    if (fq == 0) atomicAdd(ss_out + row, ssfix(sq));
                }
        } else if constexpr (!BASE_F32) {
            constexpr int MB = W8 ? 2 : 4;
            __attribute__((address_space(1))) unsigned char* h8 = (__attribute__((address_space(1))) unsigned char*)hb8;
#pragma unroll
            for (int ai = 0; ai < 2; ++ai)
#pragma unroll
            for (int mb = 0; mb < 4; mb += MB) {
                u32x4 bw[MB][2];
#pragma unroll
                for (int m = 0; m < MB; ++m)
#pragma unroll
                    for (int bj = 0; bj < 2; ++bj) bw[m][bj] = __builtin_nontemporal_load((const u32x4*)(hb + (size_t)(row0 + ai * HALF + (mb + m) * 16) * D + col0 + bj * HALF));
#pragma unroll
                for (int mm = 0; mm < MB; ++mm) {
                    const int m = mb + mm;
                    const int row = row0 + ai * HALF + m * 16; const size_t off = (size_t)row * D + col0; float sq = 0.f;
#pragma unroll
                    for (int bj = 0; bj < 2; ++bj) {
                        const u32x4 wb = bw[mm][bj];
                        const f32x4 b0 = (f32x4){bflo(wb.x), bfhi(wb.x), bflo(wb.y), bfhi(wb.y)}, b1 = (f32x4){bflo(wb.z), bfhi(wb.z), bflo(wb.w), bfhi(wb.w)};
                        const f32x4 h0 = b0 + acc[ai][bj][m][0] * scale, h1 = b1 + acc[ai][bj][m][1] * scale;
                        u32x4 w; w.x = pk(h0[0], h0[1]); w.y = pk(h0[2], h0[3]); w.z = pk(h1[0], h1[1]); w.w = pk(h1[2], h1[3]);
                        *(u32x4*)(hb + off + bj * HALF) = w;
                        if constexpr (W8) *(__attribute__((address_space(1))) u32x2*)(h8 + off + bj * HALF) = pk8(h0, h1);
#pragma unroll
                        for (int e = 0; e < 4; ++e) { const float x0 = bflo(w[e]), x1 = bfhi(w[e]); sq += x0 * x0 + x1 * x1; }
                    }
                    sq += __shfl_xor(sq, 16); sq += __shfl_xor(sq, 32);
                    if (fq == 0) atomicAdd(ss_out + row, ssfix(sq));
                }
                asm volatile("" ::: "memory");
            }
        } else {
#pragma unroll
            for (int ai = 0; ai < 2; ++ai) {
                f32x4 bf[4][2][2];
#pragma unroll
                for (int m = 0; m < 4; ++m)
#pragma unroll
                    for (int bj = 0; bj < 2; ++bj) { const float* p = basef + (size_t)(row0 + ai * HALF + m * 16) * D + col0 + bj * HALF; bf[m][bj][0] = *(const f32x4*)p; bf[m][bj][1] = *(const f32x4*)(p + 4); }
#pragma unroll
                for (int m = 0; m < 4; ++m) {
                    const int row = row0 + ai * HALF + m * 16; const size_t off = (size_t)row * D + col0; float sq = 0.f;
#pragma unroll
                    for (int bj = 0; bj < 2; ++bj) {
                        const f32x4 h0 = bf[m][bj][0] + acc[ai][bj][m][0] * scale, h1 = bf[m][bj][1] + acc[ai][bj][m][1] * scale;
                        u32x4 w; w.x = pk(h0[0], h0[1]); w.y = pk(h0[2], h0[3]); w.z = pk(h1[0], h1[1]); w.w = pk(h1[2], h1[3]);
                        *(u32x4*)(hb + off + bj * HALF) = w;
#pragma unroll
                        for (int e = 0; e < 4; ++e) { const float x0 = bflo(w[e]), x1 = bfhi(w[e]); sq += x0 * x0 + x1 * x1; }
                    }
                    sq += __shfl_xor(sq, 16); sq += __shfl_xor(sq, 32);
                    if (fq == 0) atomicAdd(ss_out + row, ssfix(sq));
                }
                asm volatile("" ::: "memory");
            }
        }
    }
};
struct EpiResFinal {
    static constexpr bool PRE = false;
    const bf16_t* hb; ss_t* ss; unsigned* cnt; const float* g; float* out; float scale;
    __device__ __forceinline__ void operator()(f32x4 (&acc)[2][2][4][2], const Unit& u, int wr, int wc, int fr, int fq, LAS unsigned char* ex) const {
        const int row0 = u.pm * BM + wr * 64 + fr, col0 = u.pn * BM + wc * 32 + 8 * fq;
        unsigned keep = 0;
#pragma unroll
        for (int ai = 0; ai < 2; ++ai) {
            u32x4 bw[4][2];
#pragma unroll
            for (int m = 0; m < 4; ++m)
#pragma unroll
                for (int bj = 0; bj < 2; ++bj) bw[m][bj] = __builtin_nontemporal_load((const u32x4*)(hb + (size_t)(row0 + ai * HALF + m * 16) * D + col0 + bj * HALF));
#pragma unroll
            for (int m = 0; m < 4; ++m) {
                const int row = row0 + ai * HALF + m * 16; float sq = 0.f;
#pragma unroll
                for (int bj = 0; bj < 2; ++bj) {
                    const u32x4 wb = bw[m][bj];
                    const f32x4 b0 = (f32x4){bflo(wb.x), bfhi(wb.x), bflo(wb.y), bfhi(wb.y)}, b1 = (f32x4){bflo(wb.z), bfhi(wb.z), bflo(wb.w), bfhi(wb.w)};
                    const f32x4 h0 = b0 + acc[ai][bj][m][0] * scale, h1 = b1 + acc[ai][bj][m][1] * scale;
                    u32x4 w; w.x = pk(h0[0], h0[1]); w.y = pk(h0[2], h0[3]); w.z = pk(h1[0], h1[1]); w.w = pk(h1[2], h1[3]);
                    const f32x4 q0 = (f32x4){bflo(w.x), bfhi(w.x), bflo(w.y), bfhi(w.y)}, q1 = (f32x4){bflo(w.z), bfhi(w.z), bflo(w.w), bfhi(w.w)};
                    acc[ai][bj][m][0] = q0; acc[ai][bj][m][1] = q1;
                    sq += (q0[0] * q0[0] + q0[1] * q0[1]) + (q0[2] * q0[2] + q0[3] * q0[3]) + (q1[0] * q1[0] + q1[1] * q1[1]) + (q1[2] * q1[2] + q1[3] * q1[3]);
                }
                sq += __shfl_xor(sq, 16); sq += __shfl_xor(sq, 32);
                if (fq == 0) keep += atomicAdd(ss + row, ssfix(sq));
            }
        }
        asm volatile("" :: "v"(keep));
        asm volatile("s_waitcnt vmcnt(0)" ::: "memory");
        if ((fr | fq) == 0) __hip_atomic_fetch_add(cnt + 64 * u.pm, 1u, __ATOMIC_RELAXED, __HIP_MEMORY_SCOPE_AGENT);
        if (wr == 0 && wc == 0) {
            unsigned spins = 0;
            while ((unsigned)__builtin_amdgcn_readfirstlane(__hip_atomic_load(cnt + 64 * u.pm, __ATOMIC_RELAXED, __HIP_MEMORY_SCOPE_AGENT)) < 32u && ++spins < (1u << 20)) __builtin_amdgcn_s_sleep(2);
            __builtin_amdgcn_fence(__ATOMIC_ACQUIRE, "agent");
            asm volatile("s_waitcnt vmcnt(0)" ::: "memory");
        }
        asm volatile("s_waitcnt lgkmcnt(0)" ::: "memory"); __builtin_amdgcn_s_barrier(); asm volatile("" ::: "memory");
        f32x4 gv[2][2];
#pragma unroll
        for (int bj = 0; bj < 2; ++bj) { gv[bj][0] = *(const f32x4*)(g + col0 + bj * HALF); gv[bj][1] = *(const f32x4*)(g + col0 + bj * HALF + 4); }
#pragma unroll
        for (int ai = 0; ai < 2; ++ai)
#pragma unroll
            for (int m = 0; m < 4; ++m) {
                const int row = row0 + ai * HALF + m * 16;
                const ss_t tot = __hip_atomic_load(ss + row, __ATOMIC_RELAXED, __HIP_MEMORY_SCOPE_AGENT);
                const float rs = __builtin_amdgcn_rsqf((float)tot * (1.0f / 256.0f) * (1.0f / D) + RMS_EPS);
                float* orow = out + (size_t)row * D + col0;
#pragma unroll
                for (int bj = 0; bj < 2; ++bj) {
                    __builtin_nontemporal_store(acc[ai][bj][m][0] * rs * gv[bj][0], (f32x4*)(orow + bj * HALF));
                    __builtin_nontemporal_store(acc[ai][bj][m][1] * rs * gv[bj][1], (f32x4*)(orow + bj * HALF + 4)); }
            }
    }
};
template <bool F8> struct EpiSoftmax {
    static constexpr bool PRE = false;
    bf16_t* P; const ss_t* ss;
    __device__ __forceinline__ void operator()(f32x4 (&acc)[2][2][4][2], const Unit& u, int wr, int wc, int fr, int fq, LAS unsigned char* ex) const {
        const int row0 = u.pm * BM + wr * 64 + fr, col0 = u.pn * BM + wc * 32 + 8 * fq;
        LAS f32x2* EX = (LAS f32x2*)ex;
        float rr[2][4];
#pragma unroll
        for (int ai = 0; ai < 2; ++ai)
#pragma unroll
            for (int m = 0; m < 4; ++m) rr[ai][m] = ssval(ss, row0 + ai * HALF + m * 16);
#pragma unroll
        for (int ai = 0; ai < 2; ++ai)
#pragma unroll
            for (int m = 0; m < 4; ++m) {
                const float r = __builtin_amdgcn_rsqf(rr[ai][m] * (1.0f / D) + RMS_EPS) * 0.0625f;
                float mx = -INFINITY;
#pragma unroll
                for (int bj = 0; bj < 2; ++bj)
#pragma unroll
                    for (int n = 0; n < 2; ++n) { f32x4 v = acc[ai][bj][m][n] * r; acc[ai][bj][m][n] = v; mx = fmaxf(mx, fmaxf(fmaxf(v[0], v[1]), fmaxf(v[2], v[3]))); }
                mx = fmaxf(mx, __shfl_xor(mx, 16)); mx = fmaxf(mx, __shfl_xor(mx, 32));
                float s = 0.f;
#pragma unroll
                for (int bj = 0; bj < 2; ++bj)
#pragma unroll
                    for (int n = 0; n < 2; ++n) { f32x4 v = acc[ai][bj][m][n]; v[0] = __expf(v[0] - mx); v[1] = __expf(v[1] - mx); v[2] = __expf(v[2] - mx); v[3] = __expf(v[3] - mx); acc[ai][bj][m][n] = v; s += (v[0] + v[1]) + (v[2] + v[3]); }
                s += __shfl_xor(s, 16); s += __shfl_xor(s, 32);
                if (fq == 0) EX[(ai * HALF + wr * 64 + m * 16 + fr) * 4 + wc] = (f32x2){mx, s};
            }
        asm volatile("s_waitcnt lgkmcnt(0)" ::: "memory"); __builtin_amdgcn_s_barrier(); asm volatile("" ::: "memory");
#pragma unroll
        for (int ai = 0; ai < 2; ++ai)
#pragma unroll
            for (int m = 0; m < 4; ++m) {
                const int rl = ai * HALF + wr * 64 + m * 16 + fr; const int row = u.pm * BM + rl;
                const f32x4 p01 = *(const LAS f32x4*)(EX + rl * 4), p23 = *(const LAS f32x4*)(EX + rl * 4 + 2);
                const float mm = fmaxf(fmaxf(p01[0], p01[2]), fmaxf(p23[0], p23[2]));
                const float l = p01[1] * __expf(p01[0] - mm) + p01[3] * __expf(p01[2] - mm) + p23[1] * __expf(p23[0] - mm) + p23[3] * __expf(p23[2] - mm);
                const float own = wc == 0 ? p01[0] : (wc == 1 ? p01[2] : (wc == 2 ? p23[0] : p23[2]));
                const float f = __expf(own - mm) * __builtin_amdgcn_rcpf(l);
                if constexpr (F8) { unsigned char* rowp = (unsigned char*)P + (size_t)row * D + col0; const float f8 = f * 256.0f;
#pragma unroll
                    for (int bj = 0; bj < 2; ++bj) *(u32x2*)(rowp + bj * HALF) = pk8(acc[ai][bj][m][0] * f8, acc[ai][bj][m][1] * f8);
                } else {
                bf16_t* rowp = P + (size_t)row * D + col0;
#pragma unroll
                for (int bj = 0; bj < 2; ++bj) { const f32x4 v0 = acc[ai][bj][m][0] * f, v1 = acc[ai][bj][m][1] * f;
                    u32x4 w; w.x = pk(v0[0], v0[1]); w.y = pk(v0[2], v0[3]); w.z = pk(v1[0], v1[1]); w.w = pk(v1[2], v1[3]);
                    *(u32x4*)(rowp + bj * HALF) = w; } }
            }
    }
};

template <class Epi, class Sched, bool FP8 = false, bool ZC = false>
__device__ __forceinline__ void gemm_phase(LAS unsigned char* lds, LAS unsigned char* ex, const Gemm g, const Sched& S, const Epi& E, int wv) {
    const int tid = opaque_tid(wv), wid = __builtin_amdgcn_readfirstlane(tid >> 6), lane = tid & 63, wr = wid >> 2, wc = wid & 3, fr = lane & 15, fq = lane >> 4;
    const int K = g.K, nt = K / BK;
    unsigned voffA[2], voffB[2];
#pragma unroll
    for (int i = 0; i < 2; ++i) { int R, C; stage_rc(tid * 16 + i * 8192, R, C); const int Rb = (R & ~31) + perm32(R & 31);
        voffA[i] = (unsigned)(R * g.lda + C) * 2u; voffB[i] = (unsigned)(Rb * g.ldb + C) * 2u; }
    const size_t kstep = (size_t)(BK * 2);
    const size_t hstepA = (size_t)HALF * g.lda * 2, hstepB = (size_t)HALF * g.ldb * 2;
    const unsigned ldsw = (unsigned)wid * 1024u;
    const int aoff = lds_byte(wr * 64 + fr, fq * 8), boff = lds_byte(wc * 32 + fr, fq * 8);
#define PG8_SA(b, h) (((b) * 2 + (h)) * HTB)
#define PG8_SB(b, h) ((4 + (b) * 2 + (h)) * HTB)
#define PG8_STAGE(bufoff, gbase, voff) do { _Pragma("unroll") for (int _i = 0; _i < 2; ++_i) \
        __builtin_amdgcn_global_load_lds((const unsigned*)((const char*)(gbase) + (voff)[_i]), (LAS unsigned*)(lds + (bufoff) + ldsw + _i * 8192), 16, 0, 0); } while (0)
#define PG8_LDA(dst, b, h) do { _Pragma("unroll") for (int m = 0; m < 4; ++m) _Pragma("unroll") for (int k = 0; k < 2; ++k) dst[m][k] = *(const LAS bf16x8*)(lds + PG8_SA(b, h) + aoff + m * 2048 + k * 1024); } while (0)
#define PG8_LDB(dst, b, h) do { _Pragma("unroll") for (int n = 0; n < 2; ++n) _Pragma("unroll") for (int k = 0; k < 2; ++k) dst[n][k] = *(const LAS bf16x8*)(lds + PG8_SB(b, h) + boff + n * 2048 + k * 1024); } while (0)
#define PG8_MMA(ai, bj, At, Bt) do { __builtin_amdgcn_s_setprio(1); _Pragma("unroll") for (int m = 0; m < 4; ++m) _Pragma("unroll") for (int n = 0; n < 2; ++n) _Pragma("unroll") for (int k = 0; k < 2; ++k) \
        { if constexpr (FP8) { const l64x2 bq_ = __builtin_bit_cast(l64x2, Bt[n][k]), aq_ = __builtin_bit_cast(l64x2, At[m][k]); \
              acc[ai][bj][m][n] = __builtin_amdgcn_mfma_f32_16x16x32_fp8_fp8(bq_[0], aq_[0], acc[ai][bj][m][n], 0, 0, 0); \
              acc[ai][bj][m][n] = __builtin_amdgcn_mfma_f32_16x16x32_fp8_fp8(bq_[1], aq_[1], acc[ai][bj][m][n], 0, 0, 0); } \
          else acc[ai][bj][m][n] = __builtin_amdgcn_mfma_f32_16x16x32_bf16(Bt[n][k], At[m][k], acc[ai][bj][m][n], 0, 0, 0); } __builtin_amdgcn_s_setprio(0); } while (0)
#define PG8_MMA_Z(ai, bj, At, Bt) do { __builtin_amdgcn_s_setprio(1); _Pragma("unroll") for (int m = 0; m < 4; ++m) _Pragma("unroll") for (int n = 0; n < 2; ++n) { \
        acc[ai][bj][m][n] = __builtin_amdgcn_mfma_f32_16x16x32_bf16(Bt[n][0], At[m][0], (f32x4){0.f, 0.f, 0.f, 0.f}, 0, 0, 0); \
        acc[ai][bj][m][n] = __builtin_amdgcn_mfma_f32_16x16x32_bf16(Bt[n][1], At[m][1], acc[ai][bj][m][n], 0, 0, 0); } __builtin_amdgcn_s_setprio(0); } while (0)
#define PG8_WAIT_V(n) asm volatile("s_waitcnt vmcnt(" #n ")" ::: "memory")
#define PG8_WAIT_L(n) asm volatile("s_waitcnt lgkmcnt(" #n ")" ::: "memory")
#define PG8_BAR __builtin_amdgcn_s_barrier()
#define PG8_SCHED __builtin_amdgcn_sched_barrier(0)
    Unit cur, nxt; int ui = 0;
    if (!S.next(0, cur)) return;
    f32x4 acc[2][2][4][2];
    if constexpr (!ZC)
#pragma unroll
    for (int a = 0; a < 2; ++a)
#pragma unroll
        for (int b = 0; b < 2; ++b)
#pragma unroll
            for (int m = 0; m < 4; ++m)
#pragma unroll
                for (int n = 0; n < 2; ++n) acc[a][b][m][n] = (f32x4){0.f, 0.f, 0.f, 0.f};
    bf16x8 At[4][2], B0[2][2], B1[2][2];
    const char* cA = (const char*)g.A + cur.aoff; const char* cB = (const char*)g.Bt + cur.boff;
    PG8_STAGE(PG8_SB(0, 0), cB, voffB); PG8_STAGE(PG8_SB(0, 1), cB + hstepB, voffB); PG8_STAGE(PG8_SA(0, 0), cA, voffA); PG8_STAGE(PG8_SA(0, 1), cA + hstepA, voffA);
    if (wr == 1) PG8_BAR;
    PG8_WAIT_V(2); PG8_BAR;
    PG8_STAGE(PG8_SB(1, 0), cB + kstep, voffB); PG8_STAGE(PG8_SA(1, 0), cA + kstep, voffA); PG8_STAGE(PG8_SB(1, 1), cB + hstepB + kstep, voffB);
    PG8_WAIT_V(6); PG8_BAR;
    for (;;) {
        const bool has_next = S.next(ui + 1, nxt);
        const char* nA = has_next ? (const char*)g.A + nxt.aoff : cA; const char* nB = has_next ? (const char*)g.Bt + nxt.boff : cB;
        if constexpr (ZC) {
            const int t = 0;
            const char* a1 = cA + (size_t)(t + 1) * kstep;
            const char* a2 = cA + (size_t)(t + 2) * kstep; const char* b2 = cB + (size_t)(t + 2) * kstep;
            const char* a3 = a2 + kstep; const char* b3 = b2 + kstep;
            PG8_LDB(B0, 0, 0); PG8_LDB(B1, 0, 1); PG8_SCHED; PG8_LDA(At, 0, 0); PG8_STAGE(PG8_SA(1, 1), a1 + hstepA, voffA);
            PG8_WAIT_V(8); PG8_WAIT_L(0); PG8_BAR; PG8_MMA_Z(0, 0, At, B0); PG8_MMA_Z(0, 1, At, B1); PG8_BAR; PG8_SCHED;
            PG8_LDA(At, 0, 1); PG8_STAGE(PG8_SB(0, 0), b2, voffB); PG8_STAGE(PG8_SB(0, 1), b2 + hstepB, voffB); PG8_STAGE(PG8_SA(0, 0), a2, voffA);
            PG8_WAIT_V(8); PG8_WAIT_L(0); PG8_BAR; PG8_MMA_Z(1, 0, At, B0); PG8_MMA_Z(1, 1, At, B1); PG8_BAR; PG8_SCHED;
            PG8_LDB(B0, 1, 0); PG8_LDB(B1, 1, 1); PG8_SCHED; PG8_LDA(At, 1, 0); PG8_STAGE(PG8_SA(0, 1), a2 + hstepA, voffA);
            PG8_WAIT_V(8); PG8_WAIT_L(0); PG8_BAR; PG8_MMA(0, 0, At, B0); PG8_MMA(0, 1, At, B1); PG8_BAR; PG8_SCHED;
            PG8_LDA(At, 1, 1); PG8_STAGE(PG8_SB(1, 0), b3, voffB); PG8_STAGE(PG8_SB(1, 1), b3 + hstepB, voffB); PG8_STAGE(PG8_SA(1, 0), a3, voffA);
            PG8_WAIT_V(8); PG8_WAIT_L(0); PG8_BAR; PG8_MMA(1, 0, At, B0); PG8_MMA(1, 1, At, B1); PG8_BAR; PG8_SCHED;
        }
#pragma unroll 1
        for (int t = ZC ? 2 : 0; t < nt; t += 2) {
            const bool last = (t == nt - 2);
            const char* a1 = cA + (size_t)(t + 1) * kstep;
            const char* a2 = last ? nA : cA + (size_t)(t + 2) * kstep; const char* b2 = last ? nB : cB + (size_t)(t + 2) * kstep;
            const char* a3 = a2 + kstep; const char* b3 = b2 + kstep;
            if constexpr (Epi::PRE) { if (last) {
                unsigned z_ = 0u; asm volatile("" : "+v"(z_));
                const unsigned off_ = (unsigned)__builtin_amdgcn_mbcnt_hi(~0u, __builtin_amdgcn_mbcnt_lo(~0u, z_)) * 4u;
                const __attribute__((address_space(1))) char* sb_ = (const __attribute__((address_space(1))) char*)(E.ss + cur.pm * BM + wr * 64);
                __builtin_amdgcn_global_load_lds((const __attribute__((address_space(1))) unsigned*)(sb_ + off_), (LAS unsigned*)(ex + wid * 512), 4, 0, 0);
                __builtin_amdgcn_global_load_lds((const __attribute__((address_space(1))) unsigned*)(sb_ + HALF * 4 + off_), (LAS unsigned*)(ex + wid * 512 + 256), 4, 0, 0); } }
            PG8_LDB(B0, 0, 0); PG8_LDB(B1, 0, 1); PG8_SCHED; PG8_LDA(At, 0, 0); PG8_STAGE(PG8_SA(1, 1), a1 + hstepA, voffA);
            PG8_WAIT_V(8); PG8_WAIT_L(0); PG8_BAR; PG8_MMA(0, 0, At, B0); PG8_MMA(0, 1, At, B1); PG8_BAR; PG8_SCHED;
            PG8_LDA(At, 0, 1); PG8_STAGE(PG8_SB(0, 0), b2, voffB); PG8_STAGE(PG8_SB(0, 1), b2 + hstepB, voffB); PG8_STAGE(PG8_SA(0, 0), a2, voffA);
            PG8_WAIT_V(8); PG8_WAIT_L(0); PG8_BAR; PG8_MMA(1, 0, At, B0); PG8_MMA(1, 1, At, B1); PG8_BAR; PG8_SCHED;
            PG8_LDB(B0, 1, 0); PG8_LDB(B1, 1, 1); PG8_SCHED; PG8_LDA(At, 1, 0); PG8_STAGE(PG8_SA(0, 1), a2 + hstepA, voffA);
            PG8_WAIT_V(8); PG8_WAIT_L(0); PG8_BAR; PG8_MMA(0, 0, At, B0); PG8_MMA(0, 1, At, B1); PG8_BAR; PG8_SCHED;
            PG8_LDA(At, 1, 1); PG8_STAGE(PG8_SB(1, 0), b3, voffB); PG8_STAGE(PG8_SB(1, 1), b3 + hstepB, voffB); PG8_STAGE(PG8_SA(1, 0), a3, voffA);
            PG8_WAIT_V(8); PG8_WAIT_L(0); PG8_BAR; PG8_MMA(1, 0, At, B0); PG8_MMA(1, 1, At, B1); PG8_BAR; PG8_SCHED;
        }
        if (wr == 0) PG8_BAR;
        {
            unsigned ze_ = 0u; asm volatile("" : "+v"(ze_));
            const int le_ = (int)__builtin_amdgcn_mbcnt_hi(~0u, __builtin_amdgcn_mbcnt_lo(~0u, ze_));
            E(acc, cur, wr, wc, le_ & 15, le_ >> 4, ex);
        }
        if (!has_next) break;
        if constexpr (!ZC)
#pragma unroll
        for (int a = 0; a < 2; ++a)
#pragma unroll
            for (int b = 0; b < 2; ++b)
#pragma unroll
                for (int m = 0; m < 4; ++m)
#pragma unroll
                    for (int n = 0; n < 2; ++n) acc[a][b][m][n] = (f32x4){0.f, 0.f, 0.f, 0.f};
        cur = nxt; cA = nA; cB = nB; ++ui;
        if (wr == 1) PG8_BAR;
    }
    PG8_WAIT_V(0);
    PG8_BAR;
#undef PG8_SA
#undef PG8_SB
#undef PG8_STAGE
#undef PG8_LDA
#undef PG8_LDB
#undef PG8_MMA
#undef PG8_MMA_Z
#undef PG8_WAIT_V
#undef PG8_WAIT_L
#undef PG8_BAR
#undef PG8_SCHED
}
}


typedef unsigned v4u __attribute__((ext_vector_type(4)));
#define XB_TMO      128
#define XB_XCNT(j)  (256  + 64 * (j))
#define XB_XSUB(j)  (1280 + 64 * (j))
#define XB_XGEN(j)  (2304 + 64 * (j))
#define XB_TOP      3328
#define XB_TOPGEN   3392
#define XCD_BAR_WORDS 3456
#define XB_SPIN_CAP (1u << 18)

__device__ __forceinline__ unsigned xb_ld(unsigned* p)              { return __hip_atomic_load(p, __ATOMIC_RELAXED, __HIP_MEMORY_SCOPE_AGENT); }
__device__ __forceinline__ unsigned xb_add(unsigned* p, unsigned v) { return __hip_atomic_fetch_add(p, v, __ATOMIC_RELAXED, __HIP_MEMORY_SCOPE_AGENT); }
__device__ __forceinline__ unsigned xb_xcc_id() { return (unsigned)__builtin_amdgcn_s_getreg((3 << 11) | 20) & 0xFu; }
#define XB_SPIN(cond, bar) do { unsigned _sp = 0; while (cond) { __builtin_amdgcn_s_sleep(1); \
    if ((++_sp & 255u) == 0u) { if (xb_ld(&(bar)[XB_TMO])) break; if (_sp > XB_SPIN_CAP) { atomicAdd(&(bar)[XB_TMO], 1u); break; } } } } while (0)

struct XcdBarrier {
    unsigned* bar; unsigned x;
    volatile LAS unsigned* st;
};

__device__ __forceinline__ XcdBarrier xcd_barrier_post(unsigned* bar, volatile LAS unsigned* st) {
    XcdBarrier b; b.bar = bar; b.x = xb_xcc_id(); b.st = st;
    if (threadIdx.x == 0) (void)xb_add(&bar[XB_XCNT(b.x)], 1u);
    return b;
}
__device__ __forceinline__ void xcd_barrier_complete(unsigned* bar, unsigned x, unsigned& nloc, unsigned& nx) {
    const unsigned G = gridDim.x * gridDim.y * gridDim.z;
    unsigned sum, cnt, mine, sp = 0u;
    for (;;) {
        sum = 0u; cnt = 0u; mine = 0u;
#pragma unroll
        for (unsigned j = 0; j < 16; ++j) { const unsigned c = xb_ld(&bar[XB_XCNT(j)]); sum += c; cnt += (c > 0u) ? 1u : 0u; mine = (j == x) ? c : mine; }
        if (sum == G) break;
        __builtin_amdgcn_s_sleep(1);
        if ((++sp & 255u) == 0u) { if (xb_ld(&bar[XB_TMO])) break; if (sp > XB_SPIN_CAP) { atomicAdd(&bar[XB_TMO], 1u); break; } }
    }
    nloc = mine > 0u ? mine : 1u; nx = cnt > 0u ? cnt : 1u;
}

__device__ __forceinline__ void xcd_barrier(const XcdBarrier& b) {
    asm volatile("s_waitcnt vmcnt(0)" ::: "memory");
    __syncthreads();
    if (threadIdx.x == 0) {
        unsigned* bar = b.bar;
        __builtin_amdgcn_s_waitcnt(0);
        unsigned nloc = b.st[0], nx = b.st[1];
        if (nloc == 0u) { xcd_barrier_complete(bar, b.x, nloc, nx); b.st[0] = nloc; b.st[1] = nx; }
        const unsigned old = xb_add(&bar[XB_XSUB(b.x)], 1u);
        const unsigned gen = old / nloc;
        if (old + 1u == (gen + 1u) * nloc) {
            __builtin_amdgcn_fence(__ATOMIC_RELEASE, "agent");
            asm volatile("s_waitcnt vmcnt(0)" ::: "memory");
            const unsigned og = xb_add(&bar[XB_TOP], 1u);
            const unsigned tg = og / nx;
            if (og + 1u == (tg + 1u) * nx) xb_add(&bar[XB_TOPGEN], 1u);
            else XB_SPIN(xb_ld(&bar[XB_TOPGEN]) == tg, bar);
            __builtin_amdgcn_fence(__ATOMIC_ACQUIRE, "agent");
            xb_add(&bar[XB_XGEN(b.x)], 1u);
            asm volatile("s_waitcnt vmcnt(0)" ::: "memory");
        } else {
            XB_SPIN(xb_ld(&bar[XB_XGEN(b.x)]) == gen, bar);
            __builtin_amdgcn_fence(__ATOMIC_ACQUIRE, "agent");
            asm volatile("s_waitcnt vmcnt(0)" ::: "memory");
        }
    }
    __syncthreads();
}

struct Args { const float* in[25]; float* out; unsigned char* ws; int ph_lo, ph_hi; };

__device__ __forceinline__ void tr_load(const float* W, int N, int nblk, const float* gain, int item, int lane, f32x4 (&v)[8]) {
    const int kb = item / nblk, nb = item % nblk, k0 = 64 * kb, n0 = 32 * nb;
#pragma unroll
    for (int i = 0; i < 8; ++i) { const int k = k0 + 8 * i + (lane >> 3); v[i] = __builtin_nontemporal_load((const __attribute__((address_space(1))) f32x4*)(W + (size_t)k * N + n0 + (lane & 7) * 4));     if (gain) v[i] = v[i] * *(const __attribute__((address_space(1))) float*)(gain + k); }
}
__device__ __forceinline__ void tr_store(const f32x4 (&v)[8], int K, int nblk, bf16_t* WT, int mode, LAS float* scr, int item, int lane) {
    const int kb = item / nblk, nb = item % nblk, k0 = 64 * kb, n0 = 32 * nb;
    int drow0 = n0;
    if (mode == 1) { drow0 = n0 < F ? (n0 / 128) * 256 + (n0 % 128) : ((n0 - F) / 128) * 256 + 128 + ((n0 - F) % 128); }
    else if (mode == 2) { if (n0 < 512) drow0 = (n0 / 128) * 256 + (n0 % 128); else if (n0 < 1024) drow0 = ((n0 - 512) / 128) * 256 + 128 + ((n0 - 512) % 128); }
    else if (mode == 3) { if (n0 >= 2048) drow0 = 1024 + ((n0 - 2048) / 128) * 256 + 128 + ((n0 - 2048) % 128); else if (n0 >= 1024) drow0 = 1024 + ((n0 - 1024) / 128) * 256 + ((n0 - 1024) % 128); }
#pragma unroll
    for (int i = 0; i < 8; ++i) { LAS float* d = scr + (8 * i + (lane >> 3)) * 33 + (lane & 7) * 4; d[0] = v[i][0]; d[1] = v[i][1]; d[2] = v[i][2]; d[3] = v[i][3]; }
    asm volatile("s_waitcnt lgkmcnt(0)" ::: "memory");
    const int c = lane & 7;
#pragma unroll
    for (int j = 0; j < 4; ++j) { const int n = (lane >> 3) + 8 * j; const LAS float* sp = scr + (8 * c) * 33 + n;
        u32x4 o; o.x = pk(sp[0 * 33], sp[1 * 33]); o.y = pk(sp[2 * 33], sp[3 * 33]); o.z = pk(sp[4 * 33], sp[5 * 33]); o.w = pk(sp[6 * 33], sp[7 * 33]);
        *(__attribute__((address_space(1))) u32x4*)(WT + (size_t)(drow0 + n) * K + k0 + 8 * c) = o; }
    asm volatile("s_waitcnt lgkmcnt(0)" ::: "memory");
}

__device__ __forceinline__ float row_to_bf16(const float* xrow, bf16_t* orow, const float* gain, bool normalize, int lane) {
    const f32x4* xr = (const f32x4*)xrow + lane;
    f32x4 v[4]; float s = 0.f;
#pragma unroll
    for (int j = 0; j < 4; ++j) { v[j] = xr[64 * j]; s += (v[j][0] * v[j][0] + v[j][1] * v[j][1]) + (v[j][2] * v[j][2] + v[j][3] * v[j][3]); }
    s = wave_sum(s);
    const float r = normalize ? __builtin_amdgcn_rsqf(s * (1.0f / D) + RMS_EPS) : 1.0f;
    u32x2* o8 = (u32x2*)orow + lane;
#pragma unroll
    for (int j = 0; j < 4; ++j) { f32x4 gv = gain ? ((const f32x4*)gain)[lane + 64 * j] : (f32x4){1.f, 1.f, 1.f, 1.f}; f32x4 y = v[j] * r * gv; o8[64 * j] = (u32x2){pk(y[0], y[1]), pk(y[2], y[3])}; }
    return s;
}

__device__ __forceinline__ void p0_prologue(const Args& a, LAS unsigned char* lds, int G, int wv) {
    const int tid = opaque_tid(wv), lane = tid & 63, wave = tid >> 6;
    const int gw = blockIdx.x * NWAVES + wave, NGW = G * NWAVES;
    unsigned char* ws = a.ws;
    LAS float* scr = (LAS float*)(lds + wave * 8704);
    struct MatDesc { const float* src; bf16_t* dst; const float* gain; int K, N, mode, start; };
    LAS MatDesc* tab = (LAS MatDesc*)(lds + 73728);
    LAS int* tab_total = (LAS int*)(lds + 73728 + 16 * sizeof(MatDesc));
    if (tid == 0) {
        int e = 0, st = 0;
#define MAT(src_, K_, N_, dst_, gain_, MODE_) { tab[e].src = (src_); tab[e].dst = (dst_); tab[e].gain = (gain_); tab[e].K = (K_); tab[e].N = (N_); tab[e].mode = (MODE_); tab[e].start = st; st += ((K_) / 64) * ((N_) / 32); ++e; }
#pragma unroll
        for (int l = 0; l < 2; ++l) {
            MAT(a.in[3] + (size_t)l * D * 2 * F, D, 2 * F, (bf16_t*)(ws + WS_WGU) + (size_t)(2 * l) * 2 * F * D, a.in[2] + l * D, 1);
            MAT(a.in[22] + (size_t)l * D * 2 * F, D, 2 * F, (bf16_t*)(ws + WS_WGU) + (size_t)(2 * l + 1) * 2 * F * D, a.in[21] + l * D, 1);
            MAT(a.in[4] + (size_t)l * F * D, F, D, (bf16_t*)(ws + WS_WDN) + (size_t)(2 * l) * F * D, (const float*)nullptr, 0);
            MAT(a.in[23] + (size_t)l * F * D, F, D, (bf16_t*)(ws + WS_WDN) + (size_t)(2 * l + 1) * F * D, (const float*)nullptr, 0);
            MAT(a.in[19] + (size_t)l * D * 2 * D, D, 2 * D, (bf16_t*)(ws + WS_WKV) + (size_t)l * 2 * D * D, (const float*)nullptr, 0);
            MAT(a.in[20] + (size_t)l * D * D, D, D, (bf16_t*)(ws + WS_WOT) + (size_t)l * D * D, (const float*)nullptr, 0);
        }
        MAT(a.in[6], D, EIN, (bf16_t*)(ws + WS_WEIN), a.in[5], 2);
        MAT(a.in[12], D, D, (bf16_t*)(ws + WS_WEOUT), (const float*)nullptr, 0);
        MAT(a.in[13], D, OIN, (bf16_t*)(ws + WS_WOIN), a.in[5] + D, 3);
        MAT(a.in[15], D, D, (bf16_t*)(ws + WS_WOOUT), (const float*)nullptr, 0);
#undef MAT
        *tab_total = st;
    }
    __syncthreads();
    {
        const int total = *tab_total;
#pragma unroll 1
        for (int g0 = gw; g0 < total; g0 += 4 * NGW) {
            int gi[4], ei[4];
#pragma unroll
            for (int q = 0; q < 4; ++q) { gi[q] = g0 + q * NGW; ei[q] = 0; }
#pragma unroll 1
            for (int e = 1; e < 16; ++e) { const int st = tab[e].start;
#pragma unroll
                for (int q = 0; q < 4; ++q) if (gi[q] >= st) ei[q] = e; }
            f32x4 v[4][8];
#pragma unroll
            for (int q = 0; q < 4; ++q) { ei[q] = __builtin_amdgcn_readfirstlane(ei[q]);
                if (gi[q] < total) { const int Nq = tab[ei[q]].N; tr_load(tab[ei[q]].src, Nq, Nq / 32, tab[ei[q]].gain, gi[q] - tab[ei[q]].start, lane, v[q]); } }
#pragma unroll
            for (int q = 0; q < 4; ++q)
                if (gi[q] < total) { const int Nq = tab[ei[q]].N; tr_store(v[q], tab[ei[q]].K, Nq / 32, tab[ei[q]].dst, tab[ei[q]].mode, scr, gi[q] - tab[ei[q]].start, lane); }
        }
    }
    for (int r = gw; r < 2 * D; r += NGW) {
        const int l = r >> 10, k = r & 1023; const float gk = a.in[16][l * D + k];
        const f32x4* src = (const f32x4*)(a.in[18] + (size_t)r * D) + lane; u32x2* dst = (u32x2*)((bf16_t*)(ws + WS_WQ) + (size_t)r * D) + lane;
#pragma unroll
        for (int j = 0; j < 4; ++j) { const f32x4 v = src[64 * j] * gk; dst[64 * j] = (u32x2){pk(v[0], v[1]), pk(v[2], v[3])}; }
    }
    for (int r = gw; r < 2 * 1024; r += NGW) {
        const int l = r >> 10, k = r & 1023;
        row_to_bf16(a.in[1] + (size_t)k * D, (bf16_t*)(ws + WS_MEMN) + (size_t)r * D, a.in[17] + l * D, true, lane);
    }
    ss_t* ss = (ss_t*)(ws + WS_SS);
    for (int r0 = gw * 4; r0 < M; r0 += NGW * 4) {
        f32x4 v[4][4];
#pragma unroll
        for (int q = 0; q < 4; ++q)
#pragma unroll
            for (int j = 0; j < 4; ++j) v[q][j] = __builtin_nontemporal_load(&((const f32x4*)(a.in[0] + (size_t)(r0 + q) * D))[lane + 64 * j]);
#pragma unroll
        for (int q = 0; q < 4; ++q) {
            float sq = 0.f; u32x2* o8 = (u32x2*)((bf16_t*)(ws + WS_HB) + (size_t)(r0 + q) * D) + lane;
#pragma unroll
            for (int j = 0; j < 4; ++j) { const f32x4 x = v[q][j]; sq += (x[0] * x[0] + x[1] * x[1]) + (x[2] * x[2] + x[3] * x[3]); o8[64 * j] = (u32x2){pk(x[0], x[1]), pk(x[2], x[3])}; }
            sq = wave_sum(sq);
            if (lane < 9) ss[(size_t)lane * M + r0 + q] = lane == 0 ? ssfix(sq) : (ss_t)0;
        }
    }
}

__device__ __forceinline__ void conv_tile(LAS unsigned char* lds, const bf16_t* Z, bf16_t* MIX, const float* cw, const float* cb, const float* lng, const float* lnb, int tile, int wv) {
    const int tid = opaque_tid(wv), lane = tid & 63, wave = tid >> 6;
    const int tok0 = tile * 32, tseq = tok0 & (SEQ - 1);
    LAS float* Y = (LAS float*)(lds + 63488);
#pragma unroll 4
    for (int id = tid; id < 62 * 64; id += NTHREADS) {
        const int j = id >> 6, c8 = id & 63; u32x4 o = (u32x4){0u, 0u, 0u, 0u};
        if (tseq - 30 + j >= 0) o = *(const u32x4*)(Z + (size_t)(tok0 - 30 + j) * ZE_LD + c8 * 8);
        *(LAS u32x4*)(lds + j * 1024 + c8 * 16) = o;
    }
    __syncthreads();
    {
        const int c = tid; float w[31];
#pragma unroll
        for (int k = 0; k < 31; ++k) w[k] = cw[k * 512 + c];
        const float bias = cb[c];
#pragma unroll 1
        for (int tg = 0; tg < 4; ++tg) {
            float av[38];
#pragma unroll
            for (int j = 0; j < 38; ++j) av[j] = __builtin_bit_cast(float, (unsigned)(*(const LAS unsigned short*)(lds + (tg * 8 + j) * 1024 + c * 2)) << 16);
#pragma unroll
            for (int t = 0; t < 8; ++t) { float y = bias;
#pragma unroll
                for (int k = 0; k < 31; ++k) y += w[k] * av[t + k];
                Y[(tg * 8 + t) * 512 + c] = y; }
            asm volatile("" ::: "memory");
        }
    }
    __syncthreads();
    {
        const f32x4 g0 = *(const f32x4*)(lng + lane * 8), g1 = *(const f32x4*)(lng + lane * 8 + 4), b0 = *(const f32x4*)(lnb + lane * 8), b1 = *(const f32x4*)(lnb + lane * 8 + 4);
#pragma unroll 1
        for (int tt = 0; tt < 4; ++tt) {
            const int t = wave * 4 + tt;
            f32x4 v0 = *(const LAS f32x4*)(Y + t * 512 + lane * 8), v1 = *(const LAS f32x4*)(Y + t * 512 + lane * 8 + 4);
            const float mean = wave_sum((v0[0] + v0[1]) + (v0[2] + v0[3]) + (v1[0] + v1[1]) + (v1[2] + v1[3])) * (1.0f / 512.0f);
            v0 = v0 - mean; v1 = v1 - mean;
            const float var = wave_sum((v0[0] * v0[0] + v0[1] * v0[1]) + (v0[2] * v0[2] + v0[3] * v0[3]) + (v1[0] * v1[0] + v1[1] * v1[1]) + (v1[2] * v1[2] + v1[3] * v1[3])) * (1.0f / 512.0f);
            const float rstd = __builtin_amdgcn_rsqf(var + LN_EPS);
            f32x4 y0 = v0 * rstd * g0 + b0, y1 = v1 * rstd * g1 + b1;
#pragma unroll
            for (int e = 0; e < 4; ++e) { y0[e] = y0[e] * sigmoidf_(y0[e]); y1[e] = y1[e] * sigmoidf_(y1[e]); }
            u32x4 o; o.x = pk(y0[0], y0[1]); o.y = pk(y0[2], y0[3]); o.z = pk(y1[0], y1[1]); o.w = pk(y1[2], y1[3]);
            *(u32x4*)(MIX + (size_t)(tok0 + t) * D + lane * 8) = o;
        }
    }
    __syncthreads();
}

constexpr int KSTR = 144, VT_OFF = 36864, VSTR = 528;
__device__ __forceinline__ void swa_unit(LAS unsigned char* lds, const bf16_t* Z, bf16_t* MIX, const float* sinks, int unit, int wv) {
    const int tid = opaque_tid(wv), lane = tid & 63, wave = tid >> 6, hi = lane >> 5, l32 = lane & 31;
    const int kh = unit & 1, n = (unit >> 1) & 63, b = unit >> 7;
    const int tok0 = b * SEQ + n * 128;
    for (int id = tid; id < 2048; id += NTHREADS) {
        const int key = id >> 3, c = id & 7; u32x4 v = (u32x4){0u, 0u, 0u, 0u};
        if (n > 0 || key >= 128) v = *(const u32x4*)(Z + (size_t)(tok0 - 128 + key) * ZE_LD + 1024 + kh * 64 + c * 8);
        *(LAS u32x4*)(lds + key * KSTR + c * 16) = v;
    }
    {
        const int key = tid & 255, half = tid >> 8; u32x4 v[4];
#pragma unroll
        for (int c = 0; c < 4; ++c) { v[c] = (u32x4){0u, 0u, 0u, 0u}; if (n > 0 || key >= 128) v[c] = *(const u32x4*)(Z + (size_t)(tok0 - 128 + key) * ZE_LD + 1152 + kh * 64 + half * 32 + c * 8); }
        const int kap = key & 31, pos = (key & ~31) + 16 * (kap >> 4) + 8 * ((kap >> 2) & 1) + 4 * ((kap >> 3) & 1) + (kap & 3);
#pragma unroll
        for (int c = 0; c < 4; ++c)
#pragma unroll
            for (int e = 0; e < 4; ++e) { const int d = half * 32 + c * 8 + e * 2;
                *(LAS unsigned short*)(lds + VT_OFF + d * VSTR + pos * 2) = (unsigned short)(v[c][e] & 0xffffu);
                *(LAS unsigned short*)(lds + VT_OFF + (d + 1) * VSTR + pos * 2) = (unsigned short)(v[c][e] >> 16); }
    }
    __syncthreads();
#pragma unroll 1
    for (int itk = 0; itk < 2; ++itk) {
        const int task = wave + 8 * itk, g = task & 3, jq = task >> 2;
        const int H = kh * 4 + g; const float slope = exp2f(-(float)(H + 1)), sink = sinks[H];
        const int qtok = tok0 + 32 * jq + l32;
        bf16x8 qf[4];
#pragma unroll
        for (int ds = 0; ds < 4; ++ds) qf[ds] = *(const bf16x8*)(Z + (size_t)qtok * ZE_LD + 512 + H * 64 + 16 * ds + 8 * hi);
        f32x16 s[5];
#pragma unroll
        for (int tt = 0; tt < 5; ++tt) {
            s[tt] = (f32x16){0.f, 0.f, 0.f, 0.f, 0.f, 0.f, 0.f, 0.f, 0.f, 0.f, 0.f, 0.f, 0.f, 0.f, 0.f, 0.f};
            const int kt = jq + tt;
            asm volatile("" ::: "memory");
#pragma unroll
            for (int ds = 0; ds < 4; ++ds) { const bf16x8 kf = *(const LAS bf16x8*)(lds + (32 * kt + l32) * KSTR + (16 * ds + 8 * hi) * 2);
                s[tt] = __builtin_amdgcn_mfma_f32_32x32x16_bf16(kf, qf[ds], s[tt], 0, 0, 0); }
        }
        float mx = sink;
        float fb = (float)(128 + l32 - 4 * hi), fk = (float)(32 * jq + 4 * hi) - (n > 0 ? 0.f : 128.f);
        asm volatile("" : "+v"(fb), "+v"(fk));
#pragma unroll
        for (int tt = 0; tt < 5; ++tt)
#pragma unroll
            for (int i = 0; i < 16; ++i) {
                const float cst = (float)(32 * tt + (i & 3) + 8 * (i >> 2)); const float fd = fb - cst;
                const bool valid = fd >= 0.f && fd < 128.f && (fk + cst) >= 0.f;
                const float v = valid ? s[tt][i] * 0.125f - slope * fd : -INFINITY;
                s[tt][i] = v; mx = fmaxf(mx, v);
            }
        mx = fmaxf(mx, __shfl_xor(mx, 32));
        float sum = 0.f;
#pragma unroll
        for (int tt = 0; tt < 5; ++tt)
#pragma unroll
            for (int i = 0; i < 16; ++i) { const float p = __expf(s[tt][i] - mx); s[tt][i] = p; sum += p; }
        sum += __shfl_xor(sum, 32);
        sum += __expf(sink - mx);
        const float inv = 1.0f / sum;
        f32x16 o[2];
        o[0] = (f32x16){0.f, 0.f, 0.f, 0.f, 0.f, 0.f, 0.f, 0.f, 0.f, 0.f, 0.f, 0.f, 0.f, 0.f, 0.f, 0.f}; o[1] = o[0];
        asm volatile("" ::: "memory"); __builtin_amdgcn_sched_barrier(0);
#pragma unroll
        for (int tt = 0; tt < 5; ++tt) {
            const int kt = jq + tt;
            asm volatile("" ::: "memory"); __builtin_amdgcn_sched_barrier(0);
#pragma unroll
            for (int j = 0; j < 2; ++j) {
                u32x4 pw; pw.x = pk(s[tt][8 * j + 0], s[tt][8 * j + 1]); pw.y = pk(s[tt][8 * j + 2], s[tt][8 * j + 3]); pw.z = pk(s[tt][8 * j + 4], s[tt][8 * j + 5]); pw.w = pk(s[tt][8 * j + 6], s[tt][8 * j + 7]);
                const bf16x8 pb = __builtin_bit_cast(bf16x8, pw);
#pragma unroll
                for (int dt = 0; dt < 2; ++dt) { const bf16x8 vf = *(const LAS bf16x8*)(lds + VT_OFF + (32 * dt + l32) * VSTR + (32 * kt + 16 * j + 8 * hi) * 2);
                    o[dt] = __builtin_amdgcn_mfma_f32_32x32x16_bf16(vf, pb, o[dt], 0, 0, 0); }
            }
        }
        bf16_t* orow = MIX + (size_t)qtok * D + 512 + H * 64;
#pragma unroll
        for (int dt = 0; dt < 2; ++dt)
#pragma unroll
            for (int q4 = 0; q4 < 4; ++q4) { const int d = 32 * dt + 8 * q4 + 4 * hi;
                *(u32x2*)(orow + d) = (u32x2){pk(o[dt][4 * q4] * inv, o[dt][4 * q4 + 1] * inv), pk(o[dt][4 * q4 + 2] * inv, o[dt][4 * q4 + 3] * inv)}; }
    }
    __syncthreads();
}

__device__ __forceinline__ void sc_unit(const bf16_t* Z, bf16_t* MIX, const float* w, int unit, int wv) {
    const int tid = opaque_tid(wv), cc = tid & 127, tg = tid >> 7;
    const int tok0 = unit * 64 + tg * 16, tseq = tok0 & (SEQ - 1), c = cc * 8;
    float w0[8], w1[8], w2[8], p2[8], p1[8];
#pragma unroll
    for (int e = 0; e < 8; ++e) { w0[e] = w[c + e]; w1[e] = w[1024 + c + e]; w2[e] = w[2048 + c + e]; p2[e] = 0.f; p1[e] = 0.f; }
    if (tseq > 0) {
#pragma unroll
        for (int back = 2; back >= 1; --back) {
            const u32x4 gv = *(const u32x4*)(Z + (size_t)(tok0 - back) * ZO_LD + 1024 + c);
#pragma unroll
            for (int e = 0; e < 4; ++e) { if (back == 2) { p2[2 * e] = bflo(gv[e]); p2[2 * e + 1] = bfhi(gv[e]); } else { p1[2 * e] = bflo(gv[e]); p1[2 * e + 1] = bfhi(gv[e]); } }
        }
    }
#pragma unroll 1
    for (int t4 = 0; t4 < 16; t4 += 8) {
    asm volatile("" ::: "memory");
#pragma unroll
    for (int t = t4; t < t4 + 8; ++t) {
        const bf16_t* p = Z + (size_t)(tok0 + t) * ZO_LD + c; const u32x4 gb = __builtin_nontemporal_load((const u32x4*)p), gv = __builtin_nontemporal_load((const u32x4*)(p + 1024));
        float cur[8], y[8];
#pragma unroll
        for (int e = 0; e < 4; ++e) { cur[2 * e] = bflo(gv[e]); cur[2 * e + 1] = bfhi(gv[e]); }
#pragma unroll
        for (int e = 0; e < 8; ++e) { const float gbv = (e & 1) ? bfhi(gb[e >> 1]) : bflo(gb[e >> 1]); y[e] = gbv * (w0[e] * p2[e] + w1[e] * p1[e] + w2[e] * cur[e]); p2[e] = p1[e]; p1[e] = cur[e]; }
        u32x4 o; o.x = pk(y[0], y[1]); o.y = pk(y[2], y[3]); o.z = pk(y[4], y[5]); o.w = pk(y[6], y[7]);
        *(u32x4*)(MIX + (size_t)(tok0 + t) * D + c) = o;
    }
    }
}

#ifndef PROBE_MASK
#define PROBE_MASK 0u
#endif
#define NREP(kind) ((((PROBE_MASK) >> (kind)) & 1u) ? 2 : 1)
constexpr int N_PHASES = 19;
__global__ void __launch_bounds__(NTHREADS, 2) fwd_mega(Args a) {
    extern __shared__ __attribute__((aligned(16))) unsigned char lds_raw[];
    LAS unsigned char* lds = (LAS unsigned char*)lds_raw;
    LAS unsigned char* ex = lds + EXCH_OFF;
    cg::grid_group grid = cg::this_grid();
    int G = gridDim.x, bx = blockIdx.x;
    int wv = __builtin_amdgcn_readfirstlane((int)threadIdx.x >> 6);
    unsigned char* ws = a.ws;
    __attribute__((address_space(1))) unsigned char* wsg = (__attribute__((address_space(1))) unsigned char*)a.ws;
#define OPQ() do { asm volatile("" : "+s"(wsg), "+s"(G), "+s"(bx), "+s"(wv)); ws = (unsigned char*)wsg; } while (0)
#define SS ((ss_t*)(ws + WS_SS))
#define HB ((bf16_t*)(ws + WS_HB))
#define MIX ((bf16_t*)(ws + WS_MIX))
#define ZH ((bf16_t*)(ws + WS_ZH))
    float* OUT = a.out;
    const int lo = a.ph_lo, hi = a.ph_hi;
#ifndef PH_MASK
#define PH_MASK 0xffffffffu
#endif
#define IN(k) (((PH_MASK >> (k)) & 1u) && lo <= (k) && (k) < hi)
#define SEAM0() do { if (IN(0) && IN(1)) { xcd_barrier(xb); } } while (0)
#define SEAM(k) do { if (IN(k) && IN((k) + 1)) { xcd_barrier(xb); } } while (0)
    if (threadIdx.x < 4) ((LAS unsigned*)(lds + BARST_OFF))[threadIdx.x] = 0u;
    __syncthreads();
    XcdBarrier xb; xb.bar = (unsigned*)(ws + WS_BAR); xb.x = 0; xb.st = (volatile LAS unsigned*)(lds + BARST_OFF);
    if (lo == 0 && hi > 1) xb = xcd_barrier_post((unsigned*)(ws + WS_BAR), (volatile LAS unsigned*)(lds + BARST_OFF));
    if (hi < 0) grid.sync();
    if (threadIdx.x == 0) { const unsigned xcc = xb_xcc_id(); const unsigned rk = atomicAdd((unsigned*)(ws + WS_CEN) + (xcc & 7u) * 16u, 1u); ((LAS unsigned*)(lds + BARST_OFF))[2] = xcc; ((LAS unsigned*)(lds + BARST_OFF))[3] = rk; }
    __syncthreads();
    if (IN(0)) { for (int rep = 0; rep < NREP(10); ++rep) p0_prologue(a, lds, G, wv); }
    SEAM0();
    if (lo == 0 && hi > 1) {
        bool even = true;
        for (int j = 0; j < 8; ++j) even = even && (__hip_atomic_load((unsigned*)(ws + WS_CEN) + j * 16, __ATOMIC_RELAXED, __HIP_MEMORY_SCOPE_AGENT) * 8u == (unsigned)G);
        const unsigned xcc = ((volatile LAS unsigned*)(lds + BARST_OFF))[2], rk = ((volatile LAS unsigned*)(lds + BARST_OFF))[3];
        if (even && (G % 8) == 0 && xcc < 8u) bx = (int)(rk * 8u + xcc);
        bx = __builtin_amdgcn_readfirstlane(bx);
    }
#pragma unroll 1
    for (int l = 0; l < 2; ++l) {
        const int pb = 1 + l * 9;
        if (IN(pb + 0)) { OPQ();
            pg8::Gemm g{HB, (const bf16_t*)(ws + WS_WGU) + (size_t)(2 * l) * 2 * F * D, D, D, D}; pg8::StdOrder S; S.init(M, 2 * F, G, bx, D, D);
            pg8::EpiSwiGLU E{ZH, SS + (size_t)(4 * l) * M}; if (NREP(0) > 1) { pg8::EpiNull EN; pg8::gemm_phase(lds, ex, g, S, EN, wv); } pg8::gemm_phase<pg8::EpiSwiGLU, pg8::StdOrder, false, true>(lds, ex, g, S, E, wv);
        }
        SEAM(pb + 0);
        if (IN(pb + 1)) { OPQ();
            pg8::Gemm g{ZH, (const bf16_t*)(ws + WS_WDN) + (size_t)(2 * l) * F * D, F, F, F}; pg8::StdOrder S; S.init(M, D, G, bx, F, F);
            { pg8::EpiRes<false> E{nullptr, HB, SS + (size_t)(4 * l + 1) * M, 0.5f, nullptr}; pg8::gemm_phase(lds, ex, g, S, E, wv); }
        }
        SEAM(pb + 1);
        if (IN(pb + 2)) { OPQ();
            if (l == 0) { { pg8::Gemm g{HB, (const bf16_t*)(ws + WS_WEIN), D, D, D}; pg8::StdOrder S; S.init(M, EIN, G, bx, D, D);
                pg8::EpiGate<0> E{ZH, ZE_LD, SS + (size_t)(4 * l + 1) * M}; for (int rep = 0; rep < NREP(2); ++rep) pg8::gemm_phase(lds, ex, g, S, E, wv); }
                { pg8::Gemm g{(const bf16_t*)(ws + WS_MEMN), (const bf16_t*)(ws + WS_WKV), D, D, D}; pg8::StdOrder S; S.init(2048, 2048, G, (bx + G / 2) % G, D, D, 2, 2048);
                  pg8::EpiBf16<false> E{(bf16_t*)(ws + WS_KV), 2048, nullptr, 1.0f}; pg8::gemm_phase(lds, ex, g, S, E, wv); } }
            else { pg8::Gemm g{HB, (const bf16_t*)(ws + WS_WOIN), D, D, D}; pg8::StdOrder S; S.init(M, OIN, G, bx, D, D);
                pg8::EpiGate<1> E{ZH, ZO_LD, SS + (size_t)(4 * l + 1) * M}; for (int rep = 0; rep < NREP(2); ++rep) pg8::gemm_phase(lds, ex, g, S, E, wv); }
        }
        SEAM(pb + 2);
        if (IN(pb + 3)) { OPQ();
            for (int rep = 0; rep < NREP(3); ++rep)
            if (l == 0) {
                for (int t = bx; t < M / 32; t += G) conv_tile(lds, ZH, MIX, a.in[7], a.in[8], a.in[9], a.in[10], t, wv);
                for (int u = bx; u < NB * 64 * 2; u += G) swa_unit(lds, ZH, MIX, a.in[11], u, wv);
                const int kfold = 256 + (lo >> 8);
                { pg8::Gemm g{(const bf16_t*)(ws + WS_KV), (const bf16_t*)(ws + WS_WQ), 2048, D, kfold}; pg8::FoldSOrder S{G, bx};
                  pg8::EpiFp8 E{ws + WS_WST, D, 1.0f}; pg8::gemm_phase(lds, ex, g, S, E, wv); }
                { pg8::Gemm g{(const bf16_t*)(ws + WS_WOT), (const bf16_t*)(ws + WS_KV), D, 2048, kfold}; pg8::FoldVOrder S{G, (bx + 128) % G};
                  pg8::EpiFp8 E{ws + WS_WVOT, D, 1.0f}; pg8::gemm_phase(lds, ex, g, S, E, wv); }
            } else {
                for (int u = bx; u < M / 64; u += G) sc_unit(ZH, MIX, a.in[14], u, wv);
            }
        }
        SEAM(pb + 3);
        if (IN(pb + 4)) { OPQ();
            pg8::Gemm g{MIX, (const bf16_t*)(ws + (l == 0 ? WS_WEOUT : WS_WOOUT)), D, D, D}; pg8::StdOrder S; S.init(M, D, G, bx, D, D);
            pg8::EpiRes<false, true> E{nullptr, HB, SS + (size_t)(4 * l + 2) * M, 1.0f, ws + WS_HB8}; pg8::gemm_phase(lds, ex, g, S, E, wv);
        }
        SEAM(pb + 4);
        if (IN(pb + 5)) { OPQ();
            pg8::Gemm g{(const bf16_t*)(ws + WS_HB8), (const bf16_t*)(ws + WS_WST + (size_t)l * 4 * D * D), D / 2, D / 2, D / 2}; pg8::StdOrder S; S.init(M, D, G, bx, D / 2, D / 2, 5, 1024);
            pg8::EpiSoftmax<true> E{MIX, SS + (size_t)(4 * l + 2) * M}; for (int rep = 0; rep < NREP(5); ++rep) pg8::gemm_phase<pg8::EpiSoftmax<true>, pg8::StdOrder, true>(lds, ex, g, S, E, wv);
        }
        SEAM(pb + 5);
        if (IN(pb + 6)) { OPQ();
            pg8::Gemm g{MIX, (const bf16_t*)(ws + WS_WVOT + (size_t)l * 4 * D * D), D / 2, D / 2, D / 2}; pg8::StdOrder S; S.init(M, D, G, bx, D / 2, D / 2, 5, 1024);
            pg8::EpiRes<false> E{nullptr, HB, SS + (size_t)(4 * l + 3) * M, 1.0f / 256.0f, nullptr}; pg8::gemm_phase<pg8::EpiRes<false>, pg8::StdOrder, true>(lds, ex, g, S, E, wv);
        }
        SEAM(pb + 6);
        if (IN(pb + 7)) { OPQ();
            pg8::Gemm g{HB, (const bf16_t*)(ws + WS_WGU) + (size_t)(2 * l + 1) * 2 * F * D, D, D, D}; pg8::StdOrder S; S.init(M, 2 * F, G, bx, D, D);
            pg8::EpiSwiGLU E{ZH, SS + (size_t)(4 * l + 3) * M}; if (NREP(7) > 1) { pg8::EpiNull EN; pg8::gemm_phase(lds, ex, g, S, EN, wv); } pg8::gemm_phase<pg8::EpiSwiGLU, pg8::StdOrder, false, true>(lds, ex, g, S, E, wv);
        }
        SEAM(pb + 7);
        if (IN(pb + 8)) { OPQ();
            pg8::Gemm g{ZH, (const bf16_t*)(ws + WS_WDN) + (size_t)(2 * l + 1) * F * D, F, F, F}; pg8::StdOrder S; S.init(M, D, G, bx, F, F);
            if (l == 0) { pg8::EpiRes<false> E{nullptr, HB, SS + (size_t)(4 * l + 4) * M, 0.5f, nullptr}; pg8::gemm_phase(lds, ex, g, S, E, wv); }
            else { pg8::EpiResFinal E{HB, SS + (size_t)8 * M, (unsigned*)(ws + WS_PCNT), a.in[24], OUT, 0.5f}; pg8::gemm_phase(lds, ex, g, S, E, wv); }
        }
        SEAM(pb + 8);
    }
#undef IN
#undef SEAM
#undef SEAM0
#undef OPQ
#undef SS
#undef HB
#undef MIX
#undef ZH
}

#ifndef N_LAUNCH_MODE
#define N_LAUNCH_MODE 0
#endif
extern "C" void kernel_launch(void* const* d_in, const int* in_sizes, int n_in, void* d_out, int out_size, void* d_ws, size_t ws_size, hipStream_t stream) {
    static int grid = 0;
    if (grid == 0) {
        int dev = 0, cus = 0, per_cu = 0;
        hipGetDevice(&dev); hipDeviceGetAttribute(&cus, hipDeviceAttributeMultiprocessorCount, dev);
        if (hipFuncSetAttribute((const void*)fwd_mega, hipFuncAttributeMaxDynamicSharedMemorySize, LDS_BYTES) != hipSuccess) { fprintf(stderr, "hipFuncSetAttribute failed\n"); grid = -1; return; }
        if (hipOccupancyMaxActiveBlocksPerMultiprocessor(&per_cu, (const void*)fwd_mega, NTHREADS, LDS_BYTES) != hipSuccess || per_cu < 1) { fprintf(stderr, "occupancy query: %d\n", per_cu); per_cu = 1; }
        (void)hipGetLastError();
        grid = cus * 1;
        if (n_in != 25 || ws_size < WS_END) { fprintf(stderr, "kernel_launch: unexpected n_in %d / ws %zu\n", n_in, ws_size); grid = -1; return; }
    }
    if (grid < 0) return;
    if (hipMemsetAsync((char*)d_ws + WS_BAR, 0, WS_PCNT + 128 * 256 - WS_BAR, stream) != hipSuccess) { fprintf(stderr, "kernel_launch: hipMemsetAsync failed\n"); return; }
    Args a{};
    for (int i = 0; i < 25; ++i) a.in[i] = (const float*)d_in[i];
    a.out = (float*)d_out; a.ws = (unsigned char*)d_ws;
#if N_LAUNCH_MODE == 0
    a.ph_lo = 0; a.ph_hi = N_PHASES;
    { void* args[] = {&a}; hipError_t e = hipLaunchCooperativeKernel((const void*)fwd_mega, dim3(grid), dim3(NTHREADS), args, LDS_BYTES, stream);
      if (e != hipSuccess) fprintf(stderr, "cooperative launch failed: %s (grid %d)\n", hipGetErrorString(e), grid); }
#else
    for (int p = 0; p < N_PHASES; ++p) {
        a.ph_lo = p; a.ph_hi = p + 1; void* args[] = {&a};
        hipError_t e = hipLaunchCooperativeKernel((const void*)fwd_mega, dim3(grid), dim3(NTHREADS), args, LDS_BYTES, stream);
        if (e != hipSuccess) { fprintf(stderr, "cooperative launch %d failed: %s (grid %d)\n", p, hipGetErrorString(e), grid); break; }
    }
#endif
}
```

```cpp
#include <hip/hip_runtime.h>
#include <hip/hip_cooperative_groups.h>
#include <cstdio>
#include <cstdint>
namespace cg = cooperative_groups;

#define LAS __attribute__((address_space(3)))
typedef unsigned short bf16_t;
typedef short bf16x8 __attribute__((ext_vector_type(8)));
typedef float f32x4 __attribute__((ext_vector_type(4)));
typedef float f32x2 __attribute__((ext_vector_type(2)));
typedef float f32x16 __attribute__((ext_vector_type(16)));
typedef unsigned u32x4 __attribute__((ext_vector_type(4)));
typedef unsigned u32x2 __attribute__((ext_vector_type(2)));
typedef __bf16 bf2_t __attribute__((ext_vector_type(2)));

constexpr int M = 32768, D = 1024, F = 2816, SEQ = 8192, NB = 4;
constexpr int EIN = 1792, OIN = 3072;
constexpr int ZE_LD = 1280, ZO_LD = 2048;
constexpr float RMS_EPS = 1e-6f, LN_EPS = 1e-5f;
constexpr int NTHREADS = 512, NWAVES = 8;
constexpr int LDS_BYTES = 147456;
constexpr int BARST_OFF = 139264;
constexpr int EXCH_OFF = 131072;

constexpr size_t MiB = 1u << 20;
constexpr size_t WS_SS = 464 * MiB;
constexpr size_t WS_BAR = 1280 * 1024;
constexpr size_t WS_CEN = 1536 * 1024;
constexpr size_t WS_PCNT = WS_CEN + 4096;
constexpr size_t WS_WGU = 2 * MiB;
constexpr size_t WS_WDN = 46 * MiB;
constexpr size_t WS_WEIN = 68 * MiB;
constexpr size_t WS_WEOUT = 72 * MiB;
constexpr size_t WS_WOIN = 74 * MiB;
constexpr size_t WS_WOOUT = 80 * MiB;
constexpr size_t WS_WQ = 82 * MiB;
constexpr size_t WS_WKV = 86 * MiB;
constexpr size_t WS_WOT = 94 * MiB;
constexpr size_t WS_MEMN = 98 * MiB;
constexpr size_t WS_KV = 102 * MiB;
constexpr size_t WS_WST = 110 * MiB;
constexpr size_t WS_WVOT = 126 * MiB;
constexpr size_t WS_HB = 144 * MiB;
constexpr size_t WS_MIX = 208 * MiB;
constexpr size_t WS_ZH = 272 * MiB;
constexpr size_t WS_HB8 = 468 * MiB;
constexpr size_t WS_END = 500 * MiB;

__device__ __forceinline__ unsigned pk(float a, float b) { f32x2 v = {a, b}; bf2_t r = __builtin_convertvector(v, bf2_t); return __builtin_bit_cast(unsigned, r); }
__device__ __forceinline__ float bflo(unsigned u) { return __builtin_bit_cast(float, u << 16); }
__device__ __forceinline__ float bfhi(unsigned u) { return __builtin_bit_cast(float, u & 0xffff0000u); }
__device__ __forceinline__ float wave_sum(float v) {
#pragma unroll
    for (int o = 1; o < 64; o <<= 1) v += __shfl_xor(v, o);
    return v;
}
__device__ __forceinline__ int opaque_tid(int wv) { unsigned z = 0u; asm volatile("" : "+v"(z)); int t = (wv << 6) | (int)__builtin_amdgcn_mbcnt_hi(~0u, __builtin_amdgcn_mbcnt_lo(~0u, z)); asm volatile("" : "+v"(t)); return t; }
typedef long l64x2 __attribute__((ext_vector_type(2)));
__device__ __forceinline__ u32x2 pk8(f32x4 a, f32x4 b) {
    int w0 = __builtin_amdgcn_cvt_pk_fp8_f32(a[0], a[1], 0, false); w0 = __builtin_amdgcn_cvt_pk_fp8_f32(a[2], a[3], w0, true);
    int w1 = __builtin_amdgcn_cvt_pk_fp8_f32(b[0], b[1], 0, false); w1 = __builtin_amdgcn_cvt_pk_fp8_f32(b[2], b[3], w1, true);
    return (u32x2){(unsigned)w0, (unsigned)w1}; }
typedef unsigned long long u64_t;
typedef unsigned ss_t;
__device__ __forceinline__ float ssval(const ss_t* ss, int row) { return (float)ss[row] * (1.0f / 256.0f); }
__device__ __forceinline__ ss_t ssfix(float sq) { return (ss_t)(sq * 256.0f + 0.5f); }
__device__ __forceinline__ float sigmoidf_(float x) { return __builtin_amdgcn_rcpf(1.0f + __expf(-x)); }

namespace pg8 {
constexpr int BM = 256, BK = 64, HALF = 128, HTB = HALF * BK * 2, STAGE_BYTES = 8 * HTB, NXCD = 8, WGM = 8;
__device__ __forceinline__ int lds_byte(int r, int c) { const int st = (r >> 4) * 2 + (c >> 5), rr = r & 15, cc = c & 31, ob = rr * 64 + cc * 2; return st * 1024 + (ob ^ (((ob >> 9) & 1) << 5)); }
__device__ __forceinline__ void stage_rc(int b, int& R, int& C) { const int st = b / 1024, sb = b % 1024, swz = sb ^ (((sb >> 9) & 1) << 5); R = (st >> 1) * 16 + swz / 64; C = (st & 1) * 32 + (swz % 64) / 2; }
__device__ __forceinline__ int perm32(int rho) { const int n = rho >> 4, i = rho & 15; return 8 * (i >> 2) + 4 * n + (i & 3); }

struct Unit { int pm, pn; unsigned aoff, boff; };
struct Gemm { const bf16_t* A; const bf16_t* Bt; int lda, ldb, K; };

struct StdOrder {
    int nM, nN, nwg, G, c; unsigned arow, brow, bbatch; int bshift;
    __device__ void init(int Mr, int Nr, int G_, int c_, int lda, int ldb, int bshift_ = 0, unsigned bbatch_rows = 0) {
        nM = Mr / BM; nN = Nr / BM; nwg = nM * nN; G = G_; c = c_; arow = (unsigned)(BM * lda * 2); brow = (unsigned)(BM * ldb * 2); bshift = bshift_; bbatch = bbatch_rows * (unsigned)(ldb * 2); }
    __device__ bool next(int i, Unit& u) const {
        const int L = i * G + c; if (L >= nwg) return false;
        int wgid = L; { const int q = nwg / NXCD, r = nwg % NXCD, xcd = wgid % NXCD, off = wgid / NXCD; wgid = (xcd < r ? xcd * (q + 1) : r * (q + 1) + (xcd - r) * q) + off; }
        const int nig = WGM * nN, gid = wgid / nig, fm = gid * WGM, gsz = (nM - fm) < WGM ? (nM - fm) : WGM;
        u.pm = fm + ((wgid % nig) % gsz); u.pn = (wgid % nig) / gsz;
        u.aoff = (unsigned)u.pm * arow; u.boff = (unsigned)u.pn * brow + (unsigned)(u.pm >> bshift) * bbatch; return true;
    }
};
struct FoldSOrder {
    int G, c;
    __device__ bool next(int i, Unit& u) const {
        const int idx = i * G + c; if (idx >= 128) return false;
        const int l = idx >> 6, r = idx & 63, bh = r >> 2, pn = r & 3, b = bh >> 2, h = bh & 3;
        u.pm = l * 16 + bh; u.pn = pn;
        u.aoff = (unsigned)(((l * 1024 + b * 256) * 2048 + h * 256) * 2);
        u.boff = (unsigned)(((l * 1024 + pn * 256) * 1024 + h * 256) * 2); return true;
    }
};
struct FoldVOrder {
    int G, c;
    __device__ bool next(int i, Unit& u) const {
        const int idx = i * G + c; if (idx >= 128) return false;
        const int l = idx >> 6, r = idx & 63, pmo = r & 3, bh = r >> 2, b = bh >> 2, h = bh & 3;
        u.pm = (l * 4 + b) * 4 + pmo; u.pn = h;
        u.aoff = (unsigned)(((l * 1024 + pmo * 256) * 1024 + h * 256) * 2);
        u.boff = (unsigned)(((l * 1024 + b * 256) * 2048 + 1024 + h * 256) * 2); return true;
    }
};

template <bool RS> struct EpiBf16 {
    static constexpr bool PRE = false;
    bf16_t* O; int ldc; const ss_t* ss; float cs;
    __device__ __forceinline__ void operator()(f32x4 (&acc)[2][2][4][2], const Unit& u, int wr, int wc, int fr, int fq, LAS unsigned char*) const {
        const int row0 = u.pm * BM + wr * 64 + fr, col0 = u.pn * BM + wc * 32 + 8 * fq;
        float rr[2][4];
#pragma unroll
        for (int ai = 0; ai < 2; ++ai)
#pragma unroll
            for (int m = 0; m < 4; ++m) rr[ai][m] = RS ? ssval(ss, row0 + ai * HALF + m * 16) : 0.f;
#pragma unroll
        for (int ai = 0; ai < 2; ++ai)
#pragma unroll
            for (int m = 0; m < 4; ++m) {
                const int row = row0 + ai * HALF + m * 16;
                float r = cs; if (RS) r *= __builtin_amdgcn_rsqf(rr[ai][m] * (1.0f / D) + RMS_EPS);
                bf16_t* rowp = O + (size_t)row * ldc + col0;
#pragma unroll
                for (int bj = 0; bj < 2; ++bj) { const f32x4 v0 = acc[ai][bj][m][0] * r, v1 = acc[ai][bj][m][1] * r;
                    u32x4 w; w.x = pk(v0[0], v0[1]); w.y = pk(v0[2], v0[3]); w.z = pk(v1[0], v1[1]); w.w = pk(v1[2], v1[3]);
                    *(u32x4*)(rowp + bj * HALF) = w; }
            }
    }
};
template <int ODD> struct EpiGate {
    static constexpr bool PRE = true; static constexpr int PRE_OFF = 0;
    bf16_t* O; int ldc; const ss_t* ss;
    __device__ __forceinline__ void operator()(f32x4 (&acc)[2][2][4][2], const Unit& u, int wr, int wc, int fr, int fq, LAS unsigned char* ex) const {
        const int row0 = u.pm * BM + wr * 64 + fr;
        const LAS unsigned* rs_lds = (const LAS unsigned*)(ex + (wr * 4 + wc) * 512);
        const bool gated = ODD ? (u.pn >= 4) : (u.pn < 4);
        const int gcol = (ODD ? 1024 + (u.pn - 4) * HALF : u.pn * HALF) + wc * 32 + 8 * fq;
        const int pcol = (ODD ? u.pn * BM : 512 + (u.pn - 4) * BM) + wc * 32 + 8 * fq;
        float rr[2][4];
#pragma unroll
        for (int ai = 0; ai < 2; ++ai)
#pragma unroll
            for (int m = 0; m < 4; ++m) rr[ai][m] = (float)rs_lds[ai * 64 + m * 16 + fr] * (1.0f / 256.0f);
        if (gated) {
#pragma unroll
            for (int ai = 0; ai < 2; ++ai)
#pragma unroll
                for (int m = 0; m < 4; ++m) {
                    const int row = row0 + ai * HALF + m * 16;
                    const float r = __builtin_amdgcn_rsqf(rr[ai][m] * (1.0f / D) + RMS_EPS);
                    float h[8];
#pragma unroll
                    for (int n = 0; n < 2; ++n)
#pragma unroll
                        for (int e = 0; e < 4; ++e) { const float x0 = acc[ai][0][m][n][e] * r, x1 = acc[ai][1][m][n][e] * r; h[n * 4 + e] = ODD ? x0 * x1 : x0 * sigmoidf_(x1); }
                    u32x4 w; w.x = pk(h[0], h[1]); w.y = pk(h[2], h[3]); w.z = pk(h[4], h[5]); w.w = pk(h[6], h[7]);
                    *(u32x4*)(O + (size_t)row * ldc + gcol) = w;
                }
        } else {
#pragma unroll
            for (int ai = 0; ai < 2; ++ai)
#pragma unroll
                for (int m = 0; m < 4; ++m) {
                    const int row = row0 + ai * HALF + m * 16;
                    const float r = __builtin_amdgcn_rsqf(rr[ai][m] * (1.0f / D) + RMS_EPS);
                    bf16_t* rowp = O + (size_t)row * ldc + pcol;
#pragma unroll
                    for (int bj = 0; bj < 2; ++bj) { const f32x4 v0 = acc[ai][bj][m][0] * r, v1 = acc[ai][bj][m][1] * r;
                        u32x4 w; w.x = pk(v0[0], v0[1]); w.y = pk(v0[2], v0[3]); w.z = pk(v1[0], v1[1]); w.w = pk(v1[2], v1[3]);
                        *(u32x4*)(rowp + bj * HALF) = w; }
                }
        }
    }
};
struct EpiFp8 {
    static constexpr bool PRE = false;
    unsigned char* O; int ldc; float cs;
    __device__ __forceinline__ void operator()(f32x4 (&acc)[2][2][4][2], const Unit& u, int wr, int wc, int fr, int fq, LAS unsigned char*) const {
        const int row0 = u.pm * BM + wr * 64 + fr, col0 = u.pn * BM + wc * 32 + 8 * fq;
#pragma unroll
        for (int ai = 0; ai < 2; ++ai)
#pragma unroll
            for (int m = 0; m < 4; ++m) { unsigned char* rowp = O + (size_t)(row0 + ai * HALF + m * 16) * ldc + col0;
#pragma unroll
                for (int bj = 0; bj < 2; ++bj) *(u32x2*)(rowp + bj * HALF) = pk8(acc[ai][bj][m][0] * cs, acc[ai][bj][m][1] * cs); }
    }
};
struct EpiNull {
    static constexpr bool PRE = false;
    __device__ __forceinline__ void operator()(f32x4 (&acc)[2][2][4][2], const Unit&, int, int, int, int, LAS unsigned char*) const {
#pragma unroll
        for (int ai = 0; ai < 2; ++ai)
#pragma unroll
            for (int bj = 0; bj < 2; ++bj)
#pragma unroll
                for (int m = 0; m < 4; ++m)
#pragma unroll
                    for (int n = 0; n < 2; ++n) asm volatile("" :: "v"(acc[ai][bj][m][n]));
    }
};
struct EpiSwiGLU {
    static constexpr bool PRE = true; static constexpr int PRE_OFF = 0;
    bf16_t* O; const ss_t* ss;
    __device__ __forceinline__ void operator()(f32x4 (&acc)[2][2][4][2], const Unit& u, int wr, int wc, int fr, int fq, LAS unsigned char* ex) const {
        const int row0 = u.pm * BM + wr * 64 + fr, col0 = u.pn * HALF + wc * 32 + 8 * fq;
        const LAS unsigned* rs_lds = (const LAS unsigned*)(ex + (wr * 4 + wc) * 512);
#pragma unroll
        for (int ai = 0; ai < 2; ++ai)
#pragma unroll
            for (int m = 0; m < 4; ++m) {
                const int row = row0 + ai * HALF + m * 16;
                const float ir2 = (float)rs_lds[ai * 64 + m * 16 + fr] * (1.0f / (256.0f * D)) + RMS_EPS, r = __builtin_amdgcn_rsqf(ir2);
                const float c1 = -1.44269504089f * r;
                float h[8];
#pragma unroll
                for (int n = 0; n < 2; ++n)
#pragma unroll
                    for (int e = 0; e < 4; e += 2) {
                        const f32x2 g2 = (f32x2){acc[ai][0][m][n][e], acc[ai][0][m][n][e + 1]}, u2 = (f32x2){acc[ai][1][m][n][e], acc[ai][1][m][n][e + 1]};
                        const f32x2 t2 = g2 * c1; f32x2 d2; d2.x = __builtin_amdgcn_exp2f(t2.x); d2.y = __builtin_amdgcn_exp2f(t2.y); d2 = d2 * ir2 + ir2;
                        f32x2 q2; q2.x = __builtin_amdgcn_rcpf(d2.x); q2.y = __builtin_amdgcn_rcpf(d2.y);
                        const f32x2 y2 = (g2 * u2) * q2; h[n * 4 + e] = y2.x; h[n * 4 + e + 1] = y2.y; }
                u32x4 w; w.x = pk(h[0], h[1]); w.y = pk(h[2], h[3]); w.z = pk(h[4], h[5]); w.w = pk(h[6], h[7]);
                *(u32x4*)(O + (size_t)row * F + col0) = w;
            }
    }
};
template <bool BASE_F32, bool W8 = false> struct EpiRes {
    static constexpr bool PRE = false;
    const float* basef; bf16_t* hb; ss_t* ss_out; float scale; unsigned char* hb8;
    __device__ __forceinline__ void operator()(f32x4 (&acc)[2][2][4][2], const Unit& u, int wr, int wc, int fr, int fq, LAS unsigned char*) const {
        const int row0 = u.pm * BM + wr * 64 + fr, col0 = u.pn * BM + wc * 32 + 8 * fq;
        if constexpr (!BASE_F32 && !W8) {
            u32x4 bw[2][4][2];
#pragma unroll
            for (int ai = 0; ai < 2; ++ai)
#pragma unroll
                for (int m = 0; m < 4; ++m)
#pragma unroll
                    for (int bj = 0; bj < 2; ++bj) bw[ai][m][bj] = *(const u32x4*)(hb + (size_t)(row0 + ai * HALF + m * 16) * D + col0 + bj * HALF);
#pragma unroll
            for (int ai = 0; ai < 2; ++ai)
#pragma unroll
                for (int m = 0; m < 4; ++m) {
                    const int row = row0 + ai * HALF + m * 16; const size_t off = (size_t)row * D + col0; float sq = 0.f;
#pragma unroll
                    for (int bj = 0; bj < 2; ++bj) {
                        const u32x4 wb = bw[ai][m][bj];
                        const f32x4 b0 = (f32x4){bflo(wb.x), bfhi(wb.x), bflo(wb.y), bfhi(wb.y)}, b1 = (f32x4){bflo(wb.z), bfhi(wb.z), bflo(wb.w), bfhi(wb.w)};
                        const f32x4 h0 = b0 + acc[ai][bj][m][0] * scale, h1 = b1 + acc[ai][bj][m][1] * scale;
                        u32x4 w; w.x = pk(h0[0], h0[1]); w.y = pk(h0[2], h0[3]); w.z = pk(h1[0], h1[1]); w.w = pk(h1[2], h1[3]);
                        *(u32x4*)(hb + off + bj * HALF) = w;
#pragma unroll
                        for (int e = 0; e < 4; ++e) { const float x0 = bflo(w[e]), x1 = bfhi(w[e]); sq += x0 * x0 + x1 * x1; }
                    }
                    sq += __shfl_xor(sq, 16); sq += __shfl_xor(sq, 32);
                    if (fq == 0) atomicAdd(ss_out + row, ssfix(sq));
                }
        } else if constexpr (!BASE_F32) {
            constexpr int MB = W8 ? 2 : 4;
            __attribute__((address_space(1))) unsigned char* h8 = (__attribute__((address_space(1))) unsigned char*)hb8;
#pragma unroll
            for (int ai = 0; ai < 2; ++ai)
#pragma unroll
            for (int mb = 0; mb < 4; mb += MB) {
                u32x4 bw[MB][2];
#pragma unroll
                for (int m = 0; m < MB; ++m)
#pragma unroll
                    for (int bj = 0; bj < 2; ++bj) bw[m][bj] = *(const u32x4*)(hb + (size_t)(row0 + ai * HALF + (mb + m) * 16) * D + col0 + bj * HALF);
#pragma unroll
                for (int mm = 0; mm < MB; ++mm) {
                    const int m = mb + mm;
                    const int row = row0 + ai * HALF + m * 16; const size_t off = (size_t)row * D + col0; float sq = 0.f;
#pragma unroll
                    for (int bj = 0; bj < 2; ++bj) {
                        const u32x4 wb = bw[mm][bj];
                        const f32x4 b0 = (f32x4){bflo(wb.x), bfhi(wb.x), bflo(wb.y), bfhi(wb.y)}, b1 = (f32x4){bflo(wb.z), bfhi(wb.z), bflo(wb.w), bfhi(wb.w)};
                        const f32x4 h0 = b0 + acc[ai][bj][m][0] * scale, h1 = b1 + acc[ai][bj][m][1] * scale;
                        u32x4 w; w.x = pk(h0[0], h0[1]); w.y = pk(h0[2], h0[3]); w.z = pk(h1[0], h1[1]); w.w = pk(h1[2], h1[3]);
                        *(u32x4*)(hb + off + bj * HALF) = w;
                        if constexpr (W8) *(__attribute__((address_space(1))) u32x2*)(h8 + off + bj * HALF) = pk8(h0, h1);
#pragma unroll
                        for (int e = 0; e < 4; ++e) { const float x0 = bflo(w[e]), x1 = bfhi(w[e]); sq += x0 * x0 + x1 * x1; }
                    }
                    sq += __shfl_xor(sq, 16); sq += __shfl_xor(sq, 32);
                    if (fq == 0) atomicAdd(ss_out + row, ssfix(sq));
                }
                asm volatile("" ::: "memory");
            }
        } else {
#pragma unroll
            for (int ai = 0; ai < 2; ++ai) {
                f32x4 bf[4][2][2];
#pragma unroll
                for (int m = 0; m < 4; ++m)
#pragma unroll
                    for (int bj = 0; bj < 2; ++bj) { const float* p = basef + (size_t)(row0 + ai * HALF + m * 16) * D + col0 + bj * HALF; bf[m][bj][0] = *(const f32x4*)p; bf[m][bj][1] = *(const f32x4*)(p + 4); }
#pragma unroll
                for (int m = 0; m < 4; ++m) {
                    const int row = row0 + ai * HALF + m * 16; const size_t off = (size_t)row * D + col0; float sq = 0.f;
#pragma unroll
                    for (int bj = 0; bj < 2; ++bj) {
                        const f32x4 h0 = bf[m][bj][0] + acc[ai][bj][m][0] * scale, h1 = bf[m][bj][1] + acc[ai][bj][m][1] * scale;
                        u32x4 w; w.x = pk(h0[0], h0[1]); w.y = pk(h0[2], h0[3]); w.z = pk(h1[0], h1[1]); w.w = pk(h1[2], h1[3]);
                        *(u32x4*)(hb + off + bj * HALF) = w;
#pragma unroll
                        for (int e = 0; e < 4; ++e) { const float x0 = bflo(w[e]), x1 = bfhi(w[e]); sq += x0 * x0 + x1 * x1; }
                    }
                    sq += __shfl_xor(sq, 16); sq += __shfl_xor(sq, 32);
                    if (fq == 0) atomicAdd(ss_out + row, ssfix(sq));
                }
                asm volatile("" ::: "memory");
            }
        }
    }
};
struct EpiResFinal {
    static constexpr bool PRE = false;
    const bf16_t* hb; ss_t* ss; unsigned* cnt; const float* g; float* out; float scale;
    __device__ __forceinline__ void operator()(f32x4 (&acc)[2][2][4][2], const Unit& u, int wr, int wc, int fr, int fq, LAS unsigned char* ex) const {
        const int row0 = u.pm * BM + wr * 64 + fr, col0 = u.pn * BM + wc * 32 + 8 * fq;
        unsigned keep = 0;
#pragma unroll
        for (int ai = 0; ai < 2; ++ai) {
            u32x4 bw[4][2];
#pragma unroll
            for (int m = 0; m < 4; ++m)
#pragma unroll
                for (int bj = 0; bj < 2; ++bj) bw[m][bj] = *(const u32x4*)(hb + (size_t)(row0 + ai * HALF + m * 16) * D + col0 + bj * HALF);
#pragma unroll
            for (int m = 0; m < 4; ++m) {
                const int row = row0 + ai * HALF + m * 16; float sq = 0.f;
#pragma unroll
                for (int bj = 0; bj < 2; ++bj) {
                    const u32x4 wb = bw[m][bj];
                    const f32x4 b0 = (f32x4){bflo(wb.x), bfhi(wb.x), bflo(wb.y), bfhi(wb.y)}, b1 = (f32x4){bflo(wb.z), bfhi(wb.z), bflo(wb.w), bfhi(wb.w)};
                    const f32x4 h0 = b0 + acc[ai][bj][m][0] * scale, h1 = b1 + acc[ai][bj][m][1] * scale;
                    u32x4 w; w.x = pk(h0[0], h0[1]); w.y = pk(h0[2], h0[3]); w.z = pk(h1[0], h1[1]); w.w = pk(h1[2], h1[3]);
                    const f32x4 q0 = (f32x4){bflo(w.x), bfhi(w.x), bflo(w.y), bfhi(w.y)}, q1 = (f32x4){bflo(w.z), bfhi(w.z), bflo(w.w), bfhi(w.w)};
                    acc[ai][bj][m][0] = q0; acc[ai][bj][m][1] = q1;
                    sq += (q0[0] * q0[0] + q0[1] * q0[1]) + (q0[2] * q0[2] + q0[3] * q0[3]) + (q1[0] * q1[0] + q1[1] * q1[1]) + (q1[2] * q1[2] + q1[3] * q1[3]);
                }
                sq += __shfl_xor(sq, 16); sq += __shfl_xor(sq, 32);
                if (fq == 0) keep += atomicAdd(ss + row, ssfix(sq));
            }
        }
        asm volatile("" :: "v"(keep));
        asm volatile("s_waitcnt vmcnt(0)" ::: "memory");
        if ((fr | fq) == 0) __hip_atomic_fetch_add(cnt + 64 * u.pm, 1u, __ATOMIC_RELAXED, __HIP_MEMORY_SCOPE_AGENT);
        if (wr == 0 && wc == 0) {
            unsigned spins = 0;
            while ((unsigned)__builtin_amdgcn_readfirstlane(__hip_atomic_load(cnt + 64 * u.pm, __ATOMIC_RELAXED, __HIP_MEMORY_SCOPE_AGENT)) < 32u && ++spins < (1u << 20)) __builtin_amdgcn_s_sleep(2);
            __builtin_amdgcn_fence(__ATOMIC_ACQUIRE, "agent");
            asm volatile("s_waitcnt vmcnt(0)" ::: "memory");
        }
        asm volatile("s_waitcnt lgkmcnt(0)" ::: "memory"); __builtin_amdgcn_s_barrier(); asm volatile("" ::: "memory");
        f32x4 gv[2][2];
#pragma unroll
        for (int bj = 0; bj < 2; ++bj) { gv[bj][0] = *(const f32x4*)(g + col0 + bj * HALF); gv[bj][1] = *(const f32x4*)(g + col0 + bj * HALF + 4); }
#pragma unroll
        for (int ai = 0; ai < 2; ++ai)
#pragma unroll
            for (int m = 0; m < 4; ++m) {
                const int row = row0 + ai * HALF + m * 16;
                const ss_t tot = __hip_atomic_load(ss + row, __ATOMIC_RELAXED, __HIP_MEMORY_SCOPE_AGENT);
                const float rs = __builtin_amdgcn_rsqf((float)tot * (1.0f / 256.0f) * (1.0f / D) + RMS_EPS);
                float* orow = out + (size_t)row * D + col0;
#pragma unroll
                for (int bj = 0; bj < 2; ++bj) {
                    __builtin_nontemporal_store(acc[ai][bj][m][0] * rs * gv[bj][0], (f32x4*)(orow + bj * HALF));
                    __builtin_nontemporal_store(acc[ai][bj][m][1] * rs * gv[bj][1], (f32x4*)(orow + bj * HALF + 4)); }
            }
    }
};
template <bool F8> struct EpiSoftmax {
    static constexpr bool PRE = true; static constexpr int PRE_OFF = 8208;
    bf16_t* P; const ss_t* ss;
    __device__ __forceinline__ void operator()(f32x4 (&acc)[2][2][4][2], const Unit& u, int wr, int wc, int fr, int fq, LAS unsigned char* ex) const {
        const int row0 = u.pm * BM + wr * 64 + fr, col0 = u.pn * BM + wc * 32 + 8 * fq;
        LAS f32x2* EX = (LAS f32x2*)ex;
        const LAS unsigned* rs_lds = (const LAS unsigned*)(ex + PRE_OFF + (wr * 4 + wc) * 512);
#pragma unroll
        for (int ai = 0; ai < 2; ++ai)
#pragma unroll
            for (int m = 0; m < 4; ++m) {
                const float r = __builtin_amdgcn_rsqf((float)rs_lds[ai * 64 + m * 16 + fr] * (1.0f / (256.0f * D)) + RMS_EPS) * 0.0625f;
                float mx = -INFINITY;
#pragma unroll
                for (int bj = 0; bj < 2; ++bj)
#pragma unroll
                    for (int n = 0; n < 2; ++n) { f32x4 v = acc[ai][bj][m][n] * r; acc[ai][bj][m][n] = v; mx = fmaxf(mx, fmaxf(fmaxf(v[0], v[1]), fmaxf(v[2], v[3]))); }
                mx = fmaxf(mx, __shfl_xor(mx, 16)); mx = fmaxf(mx, __shfl_xor(mx, 32));
                float s = 0.f;
#pragma unroll
                for (int bj = 0; bj < 2; ++bj)
#pragma unroll
                    for (int n = 0; n < 2; ++n) { f32x4 v = acc[ai][bj][m][n]; v[0] = __expf(v[0] - mx); v[1] = __expf(v[1] - mx); v[2] = __expf(v[2] - mx); v[3] = __expf(v[3] - mx); acc[ai][bj][m][n] = v; s += (v[0] + v[1]) + (v[2] + v[3]); }
                s += __shfl_xor(s, 16); s += __shfl_xor(s, 32);
                if (fq == 0) EX[(ai * HALF + wr * 64 + m * 16 + fr) * 4 + wc] = (f32x2){mx, s};
            }
        asm volatile("s_waitcnt lgkmcnt(0)" ::: "memory"); __builtin_amdgcn_s_barrier(); asm volatile("" ::: "memory");
#pragma unroll
        for (int ai = 0; ai < 2; ++ai)
#pragma unroll
            for (int m = 0; m < 4; ++m) {
                const int rl = ai * HALF + wr * 64 + m * 16 + fr; const int row = u.pm * BM + rl;
                const f32x4 p01 = *(const LAS f32x4*)(EX + rl * 4), p23 = *(const LAS f32x4*)(EX + rl * 4 + 2);
                const float mm = fmaxf(fmaxf(p01[0], p01[2]), fmaxf(p23[0], p23[2]));
                const float l = p01[1] * __expf(p01[0] - mm) + p01[3] * __expf(p01[2] - mm) + p23[1] * __expf(p23[0] - mm) + p23[3] * __expf(p23[2] - mm);
                const float own = wc == 0 ? p01[0] : (wc == 1 ? p01[2] : (wc == 2 ? p23[0] : p23[2]));
                const float f = __expf(own - mm) * __builtin_amdgcn_rcpf(l);
                if constexpr (F8) { unsigned char* rowp = (unsigned char*)P + (size_t)row * D + col0; const float f8 = f * 256.0f;
#pragma unroll
                    for (int bj = 0; bj < 2; ++bj) *(u32x2*)(rowp + bj * HALF) = pk8(acc[ai][bj][m][0] * f8, acc[ai][bj][m][1] * f8);
                } else {
                bf16_t* rowp = P + (size_t)row * D + col0;
#pragma unroll
                for (int bj = 0; bj < 2; ++bj) { const f32x4 v0 = acc[ai][bj][m][0] * f, v1 = acc[ai][bj][m][1] * f;
                    u32x4 w; w.x = pk(v0[0], v0[1]); w.y = pk(v0[2], v0[3]); w.z = pk(v1[0], v1[1]); w.w = pk(v1[2], v1[3]);
                    *(u32x4*)(rowp + bj * HALF) = w; } }
            }
    }
};

template <class Epi, class Sched, bool FP8 = false, bool ZC = false>
__device__ __forceinline__ void gemm_phase(LAS unsigned char* lds, LAS unsigned char* ex, const Gemm g, const Sched& S, const Epi& E, int wv) {
    const int tid = opaque_tid(wv), wid = __builtin_amdgcn_readfirstlane(tid >> 6), lane = tid & 63, wr = wid >> 2, wc = wid & 3, fr = lane & 15, fq = lane >> 4;
    const int K = g.K, nt = K / BK;
    unsigned voffA[2], voffB[2];
#pragma unroll
    for (int i = 0; i < 2; ++i) { int R, C; stage_rc(tid * 16 + i * 8192, R, C); const int Rb = (R & ~31) + perm32(R & 31);
        voffA[i] = (unsigned)(R * g.lda + C) * 2u; voffB[i] = (unsigned)(Rb * g.ldb + C) * 2u; }
    const size_t kstep = (size_t)(BK * 2);
    const size_t hstepA = (size_t)HALF * g.lda * 2, hstepB = (size_t)HALF * g.ldb * 2;
    const unsigned ldsw = (unsigned)wid * 1024u;
    const int aoff = lds_byte(wr * 64 + fr, fq * 8), boff = lds_byte(wc * 32 + fr, fq * 8);
#define PG8_SA(b, h) (((b) * 2 + (h)) * HTB)
#define PG8_SB(b, h) ((4 + (b) * 2 + (h)) * HTB)
#define PG8_STAGE(bufoff, gbase, voff) do { _Pragma("unroll") for (int _i = 0; _i < 2; ++_i) \
        __builtin_amdgcn_global_load_lds((const unsigned*)((const char*)(gbase) + (voff)[_i]), (LAS unsigned*)(lds + (bufoff) + ldsw + _i * 8192), 16, 0, 0); } while (0)
#define PG8_LDA(dst, b, h) do { _Pragma("unroll") for (int m = 0; m < 4; ++m) _Pragma("unroll") for (int k = 0; k < 2; ++k) dst[m][k] = *(const LAS bf16x8*)(lds + PG8_SA(b, h) + aoff + m * 2048 + k * 1024); } while (0)
#define PG8_LDB(dst, b, h) do { _Pragma("unroll") for (int n = 0; n < 2; ++n) _Pragma("unroll") for (int k = 0; k < 2; ++k) dst[n][k] = *(const LAS bf16x8*)(lds + PG8_SB(b, h) + boff + n * 2048 + k * 1024); } while (0)
#define PG8_MMA(ai, bj, At, Bt) do { __builtin_amdgcn_s_setprio(1); _Pragma("unroll") for (int m = 0; m < 4; ++m) _Pragma("unroll") for (int n = 0; n < 2; ++n) _Pragma("unroll") for (int k = 0; k < 2; ++k) \
        { if constexpr (FP8) { const l64x2 bq_ = __builtin_bit_cast(l64x2, Bt[n][k]), aq_ = __builtin_bit_cast(l64x2, At[m][k]); \
              acc[ai][bj][m][n] = __builtin_amdgcn_mfma_f32_16x16x32_fp8_fp8(bq_[0], aq_[0], acc[ai][bj][m][n], 0, 0, 0); \
              acc[ai][bj][m][n] = __builtin_amdgcn_mfma_f32_16x16x32_fp8_fp8(bq_[1], aq_[1], acc[ai][bj][m][n], 0, 0, 0); } \
          else acc[ai][bj][m][n] = __builtin_amdgcn_mfma_f32_16x16x32_bf16(Bt[n][k], At[m][k], acc[ai][bj][m][n], 0, 0, 0); } __builtin_amdgcn_s_setprio(0); } while (0)
#define PG8_MMA_Z(ai, bj, At, Bt) do { __builtin_amdgcn_s_setprio(1); _Pragma("unroll") for (int m = 0; m < 4; ++m) _Pragma("unroll") for (int n = 0; n < 2; ++n) { \
        acc[ai][bj][m][n] = __builtin_amdgcn_mfma_f32_16x16x32_bf16(Bt[n][0], At[m][0], (f32x4){0.f, 0.f, 0.f, 0.f}, 0, 0, 0); \
        acc[ai][bj][m][n] = __builtin_amdgcn_mfma_f32_16x16x32_bf16(Bt[n][1], At[m][1], acc[ai][bj][m][n], 0, 0, 0); } __builtin_amdgcn_s_setprio(0); } while (0)
#define PG8_WAIT_V(n) asm volatile("s_waitcnt vmcnt(" #n ")" ::: "memory")
#define PG8_WAIT_L(n) asm volatile("s_waitcnt lgkmcnt(" #n ")" ::: "memory")
#define PG8_BAR __builtin_amdgcn_s_barrier()
#define PG8_SCHED __builtin_amdgcn_sched_barrier(0)
    Unit cur, nxt; int ui = 0;
    if (!S.next(0, cur)) return;
    f32x4 acc[2][2][4][2];
    if constexpr (!ZC)
#pragma unroll
    for (int a = 0; a < 2; ++a)
#pragma unroll
        for (int b = 0; b < 2; ++b)
#pragma unroll
            for (int m = 0; m < 4; ++m)
#pragma unroll
                for (int n = 0; n < 2; ++n) acc[a][b][m][n] = (f32x4){0.f, 0.f, 0.f, 0.f};
    bf16x8 At[4][2], B0[2][2], B1[2][2];
    const char* cA = (const char*)g.A + cur.aoff; const char* cB = (const char*)g.Bt + cur.boff;
    PG8_STAGE(PG8_SB(0, 0), cB, voffB); PG8_STAGE(PG8_SB(0, 1), cB + hstepB, voffB); PG8_STAGE(PG8_SA(0, 0), cA, voffA); PG8_STAGE(PG8_SA(0, 1), cA + hstepA, voffA);
    if (wr == 1) PG8_BAR;
    PG8_WAIT_V(2); PG8_BAR;
    PG8_STAGE(PG8_SB(1, 0), cB + kstep, voffB); PG8_STAGE(PG8_SA(1, 0), cA + kstep, voffA); PG8_STAGE(PG8_SB(1, 1), cB + hstepB + kstep, voffB);
    PG8_WAIT_V(6); PG8_BAR;
    for (;;) {
        const bool has_next = S.next(ui + 1, nxt);
        const char* nA = has_next ? (const char*)g.A + nxt.aoff : cA; const char* nB = has_next ? (const char*)g.Bt + nxt.boff : cB;
        if constexpr (ZC) {
            const int t = 0;
            const char* a1 = cA + (size_t)(t + 1) * kstep;
            const char* a2 = cA + (size_t)(t + 2) * kstep; const char* b2 = cB + (size_t)(t + 2) * kstep;
            const char* a3 = a2 + kstep; const char* b3 = b2 + kstep;
            PG8_LDB(B0, 0, 0); PG8_LDB(B1, 0, 1); PG8_SCHED; PG8_LDA(At, 0, 0); PG8_STAGE(PG8_SA(1, 1), a1 + hstepA, voffA);
            PG8_WAIT_V(8); PG8_WAIT_L(0); PG8_BAR; PG8_MMA_Z(0, 0, At, B0); PG8_MMA_Z(0, 1, At, B1); PG8_BAR; PG8_SCHED;
            PG8_LDA(At, 0, 1); PG8_STAGE(PG8_SB(0, 0), b2, voffB); PG8_STAGE(PG8_SB(0, 1), b2 + hstepB, voffB); PG8_STAGE(PG8_SA(0, 0), a2, voffA);
            PG8_WAIT_V(8); PG8_WAIT_L(0); PG8_BAR; PG8_MMA_Z(1, 0, At, B0); PG8_MMA_Z(1, 1, At, B1); PG8_BAR; PG8_SCHED;
            PG8_LDB(B0, 1, 0); PG8_LDB(B1, 1, 1); PG8_SCHED; PG8_LDA(At, 1, 0); PG8_STAGE(PG8_SA(0, 1), a2 + hstepA, voffA);
            PG8_WAIT_V(8); PG8_WAIT_L(0); PG8_BAR; PG8_MMA(0, 0, At, B0); PG8_MMA(0, 1, At, B1); PG8_BAR; PG8_SCHED;
            PG8_LDA(At, 1, 1); PG8_STAGE(PG8_SB(1, 0), b3, voffB); PG8_STAGE(PG8_SB(1, 1), b3 + hstepB, voffB); PG8_STAGE(PG8_SA(1, 0), a3, voffA);
            PG8_WAIT_V(8); PG8_WAIT_L(0); PG8_BAR; PG8_MMA(1, 0, At, B0); PG8_MMA(1, 1, At, B1); PG8_BAR; PG8_SCHED;
        }
#pragma unroll 1
        for (int t = ZC ? 2 : 0; t < nt; t += 2) {
            const bool last = (t == nt - 2);
            const char* a1 = cA + (size_t)(t + 1) * kstep;
            const char* a2 = last ? nA : cA + (size_t)(t + 2) * kstep; const char* b2 = last ? nB : cB + (size_t)(t + 2) * kstep;
            const char* a3 = a2 + kstep; const char* b3 = b2 + kstep;
            if constexpr (Epi::PRE) { if (last) {
                unsigned z_ = 0u; asm volatile("" : "+v"(z_));
                const unsigned off_ = (unsigned)__builtin_amdgcn_mbcnt_hi(~0u, __builtin_amdgcn_mbcnt_lo(~0u, z_)) * 4u;
                const __attribute__((address_space(1))) char* sb_ = (const __attribute__((address_space(1))) char*)(E.ss + cur.pm * BM + wr * 64);
                __builtin_amdgcn_global_load_lds((const __attribute__((address_space(1))) unsigned*)(sb_ + off_), (LAS unsigned*)(ex + Epi::PRE_OFF + wid * 512), 4, 0, 0);
                __builtin_amdgcn_global_load_lds((const __attribute__((address_space(1))) unsigned*)(sb_ + HALF * 4 + off_), (LAS unsigned*)(ex + Epi::PRE_OFF + wid * 512 + 256), 4, 0, 0); } }
            PG8_LDB(B0, 0, 0); PG8_LDB(B1, 0, 1); PG8_SCHED; PG8_LDA(At, 0, 0); PG8_STAGE(PG8_SA(1, 1), a1 + hstepA, voffA);
            PG8_WAIT_V(8); PG8_WAIT_L(0); PG8_BAR; PG8_MMA(0, 0, At, B0); PG8_MMA(0, 1, At, B1); PG8_BAR; PG8_SCHED;
            PG8_LDA(At, 0, 1); PG8_STAGE(PG8_SB(0, 0), b2, voffB); PG8_STAGE(PG8_SB(0, 1), b2 + hstepB, voffB); PG8_STAGE(PG8_SA(0, 0), a2, voffA);
            PG8_WAIT_V(8); PG8_WAIT_L(0); PG8_BAR; PG8_MMA(1, 0, At, B0); PG8_MMA(1, 1, At, B1); PG8_BAR; PG8_SCHED;
            PG8_LDB(B0, 1, 0); PG8_LDB(B1, 1, 1); PG8_SCHED; PG8_LDA(At, 1, 0); PG8_STAGE(PG8_SA(0, 1), a2 + hstepA, voffA);
            PG8_WAIT_V(8); PG8_WAIT_L(0); PG8_BAR; PG8_MMA(0, 0, At, B0); PG8_MMA(0, 1, At, B1); PG8_BAR; PG8_SCHED;
            PG8_LDA(At, 1, 1); PG8_STAGE(PG8_SB(1, 0), b3, voffB); PG8_STAGE(PG8_SB(1, 1), b3 + hstepB, voffB); PG8_STAGE(PG8_SA(1, 0), a3, voffA);
            PG8_WAIT_V(8); PG8_WAIT_L(0); PG8_BAR; PG8_MMA(1, 0, At, B0); PG8_MMA(1, 1, At, B1); PG8_BAR; PG8_SCHED;
        }
        if (wr == 0) PG8_BAR;
        {
            unsigned ze_ = 0u; asm volatile("" : "+v"(ze_));
            const int le_ = (int)__builtin_amdgcn_mbcnt_hi(~0u, __builtin_amdgcn_mbcnt_lo(~0u, ze_));
            E(acc, cur, wr, wc, le_ & 15, le_ >> 4, ex);
        }
        if (!has_next) break;
        if constexpr (!ZC)
#pragma unroll
        for (int a = 0; a < 2; ++a)
#pragma unroll
            for (int b = 0; b < 2; ++b)
#pragma unroll
                for (int m = 0; m < 4; ++m)
#pragma unroll
                    for (int n = 0; n < 2; ++n) acc[a][b][m][n] = (f32x4){0.f, 0.f, 0.f, 0.f};
        cur = nxt; cA = nA; cB = nB; ++ui;
        if (wr == 1) PG8_BAR;
    }
    PG8_WAIT_V(0);
    PG8_BAR;
#undef PG8_SA
#undef PG8_SB
#undef PG8_STAGE
#undef PG8_LDA
#undef PG8_LDB
#undef PG8_MMA
#undef PG8_MMA_Z
#undef PG8_WAIT_V
#undef PG8_WAIT_L
#undef PG8_BAR
#undef PG8_SCHED
}
}


typedef unsigned v4u __attribute__((ext_vector_type(4)));
#define XB_TMO      128
#define XB_XCNT(j)  (256  + 64 * (j))
#define XB_XSUB(j)  (1280 + 64 * (j))
#define XB_XGEN(j)  (2304 + 64 * (j))
#define XB_TOP      3328
#define XB_TOPGEN   3392
#define XCD_BAR_WORDS 3456
#define XB_SPIN_CAP (1u << 18)

__device__ __forceinline__ unsigned xb_ld(unsigned* p)              { return __hip_atomic_load(p, __ATOMIC_RELAXED, __HIP_MEMORY_SCOPE_AGENT); }
__device__ __forceinline__ unsigned xb_add(unsigned* p, unsigned v) { return __hip_atomic_fetch_add(p, v, __ATOMIC_RELAXED, __HIP_MEMORY_SCOPE_AGENT); }
__device__ __forceinline__ unsigned xb_xcc_id() { return (unsigned)__builtin_amdgcn_s_getreg((3 << 11) | 20) & 0xFu; }
#define XB_SPIN(cond, bar) do { unsigned _sp = 0; while (cond) { __builtin_amdgcn_s_sleep(1); \
    if ((++_sp & 255u) == 0u) { if (xb_ld(&(bar)[XB_TMO])) break; if (_sp > XB_SPIN_CAP) { atomicAdd(&(bar)[XB_TMO], 1u); break; } } } } while (0)

struct XcdBarrier {
    unsigned* bar; unsigned x;
    volatile LAS unsigned* st;
};

__device__ __forceinline__ XcdBarrier xcd_barrier_post(unsigned* bar, volatile LAS unsigned* st) {
    XcdBarrier b; b.bar = bar; b.x = xb_xcc_id(); b.st = st;
    if (threadIdx.x == 0) (void)xb_add(&bar[XB_XCNT(b.x)], 1u);
    return b;
}
__device__ __forceinline__ void xcd_barrier_complete(unsigned* bar, unsigned x, unsigned& nloc, unsigned& nx) {
    const unsigned G = gridDim.x * gridDim.y * gridDim.z;
    unsigned sum, cnt, mine, sp = 0u;
    for (;;) {
        sum = 0u; cnt = 0u; mine = 0u;
#pragma unroll
        for (unsigned j = 0; j < 16; ++j) { const unsigned c = xb_ld(&bar[XB_XCNT(j)]); sum += c; cnt += (c > 0u) ? 1u : 0u; mine = (j == x) ? c : mine; }
        if (sum == G) break;
        __builtin_amdgcn_s_sleep(1);
        if ((++sp & 255u) == 0u) { if (xb_ld(&bar[XB_TMO])) break; if (sp > XB_SPIN_CAP) { atomicAdd(&bar[XB_TMO], 1u); break; } }
    }
    nloc = mine > 0u ? mine : 1u; nx = cnt > 0u ? cnt : 1u;
}

__device__ __forceinline__ void xcd_barrier(const XcdBarrier& b) {
    asm volatile("s_waitcnt vmcnt(0)" ::: "memory");
    __syncthreads();
    if (threadIdx.x == 0) {
        unsigned* bar = b.bar;
        __builtin_amdgcn_s_waitcnt(0);
        unsigned nloc = b.st[0], nx = b.st[1];
        if (nloc == 0u) { xcd_barrier_complete(bar, b.x, nloc, nx); b.st[0] = nloc; b.st[1] = nx; }
        const unsigned old = xb_add(&bar[XB_XSUB(b.x)], 1u);
        const unsigned gen = old / nloc;
        if (old + 1u == (gen + 1u) * nloc) {
            __builtin_amdgcn_fence(__ATOMIC_RELEASE, "agent");
            asm volatile("s_waitcnt vmcnt(0)" ::: "memory");
            const unsigned og = xb_add(&bar[XB_TOP], 1u);
            const unsigned tg = og / nx;
            if (og + 1u == (tg + 1u) * nx) xb_add(&bar[XB_TOPGEN], 1u);
            else XB_SPIN(xb_ld(&bar[XB_TOPGEN]) == tg, bar);
            __builtin_amdgcn_fence(__ATOMIC_ACQUIRE, "agent");
            xb_add(&bar[XB_XGEN(b.x)], 1u);
            asm volatile("s_waitcnt vmcnt(0)" ::: "memory");
        } else {
            XB_SPIN(xb_ld(&bar[XB_XGEN(b.x)]) == gen, bar);
            __builtin_amdgcn_fence(__ATOMIC_ACQUIRE, "agent");
            asm volatile("s_waitcnt vmcnt(0)" ::: "memory");
        }
    }
    __syncthreads();
}

struct Args { const float* in[25]; float* out; unsigned char* ws; int ph_lo, ph_hi; };

__device__ __forceinline__ void tr_load(const float* W, int N, int nblk, const float* gain, int item, int lane, f32x4 (&v)[8]) {
    const int kb = item / nblk, nb = item % nblk, k0 = 64 * kb, n0 = 32 * nb;
#pragma unroll
    for (int i = 0; i < 8; ++i) { const int k = k0 + 8 * i + (lane >> 3); v[i] = __builtin_nontemporal_load((const __attribute__((address_space(1))) f32x4*)(W + (size_t)k * N + n0 + (lane & 7) * 4));     if (gain) v[i] = v[i] * *(const __attribute__((address_space(1))) float*)(gain + k); }
}
__device__ __forceinline__ void tr_store(const f32x4 (&v)[8], int K, int nblk, bf16_t* WT, int mode, LAS float* scr, int item, int lane) {
    const int kb = item / nblk, nb = item % nblk, k0 = 64 * kb, n0 = 32 * nb;
    int drow0 = n0;
    if (mode == 1) { drow0 = n0 < F ? (n0 / 128) * 256 + (n0 % 128) : ((n0 - F) / 128) * 256 + 128 + ((n0 - F) % 128); }
    else if (mode == 2) { if (n0 < 512) drow0 = (n0 / 128) * 256 + (n0 % 128); else if (n0 < 1024) drow0 = ((n0 - 512) / 128) * 256 + 128 + ((n0 - 512) % 128); }
    else if (mode == 3) { if (n0 >= 2048) drow0 = 1024 + ((n0 - 2048) / 128) * 256 + 128 + ((n0 - 2048) % 128); else if (n0 >= 1024) drow0 = 1024 + ((n0 - 1024) / 128) * 256 + ((n0 - 1024) % 128); }
#pragma unroll
    for (int i = 0; i < 8; ++i) { LAS float* d = scr + (8 * i + (lane >> 3)) * 33 + (lane & 7) * 4; d[0] = v[i][0]; d[1] = v[i][1]; d[2] = v[i][2]; d[3] = v[i][3]; }
    asm volatile("s_waitcnt lgkmcnt(0)" ::: "memory");
    const int c = lane & 7;
#pragma unroll
    for (int j = 0; j < 4; ++j) { const int n = (lane >> 3) + 8 * j; const LAS float* sp = scr + (8 * c) * 33 + n;
        u32x4 o; o.x = pk(sp[0 * 33], sp[1 * 33]); o.y = pk(sp[2 * 33], sp[3 * 33]); o.z = pk(sp[4 * 33], sp[5 * 33]); o.w = pk(sp[6 * 33], sp[7 * 33]);
        *(__attribute__((address_space(1))) u32x4*)(WT + (size_t)(drow0 + n) * K + k0 + 8 * c) = o; }
    asm volatile("s_waitcnt lgkmcnt(0)" ::: "memory");
}

__device__ __forceinline__ float row_to_bf16(const float* xrow, bf16_t* orow, const float* gain, bool normalize, int lane) {
    const f32x4* xr = (const f32x4*)xrow + lane;
    f32x4 v[4]; float s = 0.f;
#pragma unroll
    for (int j = 0; j < 4; ++j) { v[j] = xr[64 * j]; s += (v[j][0] * v[j][0] + v[j][1] * v[j][1]) + (v[j][2] * v[j][2] + v[j][3] * v[j][3]); }
    s = wave_sum(s);
    const float r = normalize ? __builtin_amdgcn_rsqf(s * (1.0f / D) + RMS_EPS) : 1.0f;
    u32x2* o8 = (u32x2*)orow + lane;
#pragma unroll
    for (int j = 0; j < 4; ++j) { f32x4 gv = gain ? ((const f32x4*)gain)[lane + 64 * j] : (f32x4){1.f, 1.f, 1.f, 1.f}; f32x4 y = v[j] * r * gv; o8[64 * j] = (u32x2){pk(y[0], y[1]), pk(y[2], y[3])}; }
    return s;
}

__device__ __forceinline__ void p0_prologue(const Args& a, LAS unsigned char* lds, int G, int wv) {
    const int tid = opaque_tid(wv), lane = tid & 63, wave = tid >> 6;
    const int gw = blockIdx.x * NWAVES + wave, NGW = G * NWAVES;
    unsigned char* ws = a.ws;
    LAS float* scr = (LAS float*)(lds + wave * 8704);
    struct MatDesc { const float* src; bf16_t* dst; const float* gain; int K, N, mode, start; };
    LAS MatDesc* tab = (LAS MatDesc*)(lds + 73728);
    LAS int* tab_total = (LAS int*)(lds + 73728 + 16 * sizeof(MatDesc));
    if (tid == 0) {
        int e = 0, st = 0;
#define MAT(src_, K_, N_, dst_, gain_, MODE_) { tab[e].src = (src_); tab[e].dst = (dst_); tab[e].gain = (gain_); tab[e].K = (K_); tab[e].N = (N_); tab[e].mode = (MODE_); tab[e].start = st; st += ((K_) / 64) * ((N_) / 32); ++e; }
#pragma unroll
        for (int l = 0; l < 2; ++l) {
            MAT(a.in[3] + (size_t)l * D * 2 * F, D, 2 * F, (bf16_t*)(ws + WS_WGU) + (size_t)(2 * l) * 2 * F * D, a.in[2] + l * D, 1);
            MAT(a.in[22] + (size_t)l * D * 2 * F, D, 2 * F, (bf16_t*)(ws + WS_WGU) + (size_t)(2 * l + 1) * 2 * F * D, a.in[21] + l * D, 1);
            MAT(a.in[4] + (size_t)l * F * D, F, D, (bf16_t*)(ws + WS_WDN) + (size_t)(2 * l) * F * D, (const float*)nullptr, 0);
            MAT(a.in[23] + (size_t)l * F * D, F, D, (bf16_t*)(ws + WS_WDN) + (size_t)(2 * l + 1) * F * D, (const float*)nullptr, 0);
            MAT(a.in[19] + (size_t)l * D * 2 * D, D, 2 * D, (bf16_t*)(ws + WS_WKV) + (size_t)l * 2 * D * D, (const float*)nullptr, 0);
            MAT(a.in[20] + (size_t)l * D * D, D, D, (bf16_t*)(ws + WS_WOT) + (size_t)l * D * D, (const float*)nullptr, 0);
        }
        MAT(a.in[6], D, EIN, (bf16_t*)(ws + WS_WEIN), a.in[5], 2);
        MAT(a.in[12], D, D, (bf16_t*)(ws + WS_WEOUT), (const float*)nullptr, 0);
        MAT(a.in[13], D, OIN, (bf16_t*)(ws + WS_WOIN), a.in[5] + D, 3);
        MAT(a.in[15], D, D, (bf16_t*)(ws + WS_WOOUT), (const float*)nullptr, 0);
#undef MAT
        *tab_total = st;
    }
    __syncthreads();
    {
        const int total = *tab_total;
#pragma unroll 1
        for (int g0 = gw; g0 < total; g0 += 4 * NGW) {
            int gi[4], ei[4];
#pragma unroll
            for (int q = 0; q < 4; ++q) { gi[q] = g0 + q * NGW; ei[q] = 0; }
#pragma unroll 1
            for (int e = 1; e < 16; ++e) { const int st = tab[e].start;
#pragma unroll
                for (int q = 0; q < 4; ++q) if (gi[q] >= st) ei[q] = e; }
            f32x4 v[4][8];
#pragma unroll
            for (int q = 0; q < 4; ++q) { ei[q] = __builtin_amdgcn_readfirstlane(ei[q]);
                if (gi[q] < total) { const int Nq = tab[ei[q]].N; tr_load(tab[ei[q]].src, Nq, Nq / 32, tab[ei[q]].gain, gi[q] - tab[ei[q]].start, lane, v[q]); } }
#pragma unroll
            for (int q = 0; q < 4; ++q)
                if (gi[q] < total) { const int Nq = tab[ei[q]].N; tr_store(v[q], tab[ei[q]].K, Nq / 32, tab[ei[q]].dst, tab[ei[q]].mode, scr, gi[q] - tab[ei[q]].start, lane); }
        }
    }
    for (int r = gw; r < 2 * D; r += NGW) {
        const int l = r >> 10, k = r & 1023; const float gk = a.in[16][l * D + k];
        const f32x4* src = (const f32x4*)(a.in[18] + (size_t)r * D) + lane; u32x2* dst = (u32x2*)((bf16_t*)(ws + WS_WQ) + (size_t)r * D) + lane;
#pragma unroll
        for (int j = 0; j < 4; ++j) { const f32x4 v = src[64 * j] * gk; dst[64 * j] = (u32x2){pk(v[0], v[1]), pk(v[2], v[3])}; }
    }
    for (int r = gw; r < 2 * 1024; r += NGW) {
        const int l = r >> 10, k = r & 1023;
        row_to_bf16(a.in[1] + (size_t)k * D, (bf16_t*)(ws + WS_MEMN) + (size_t)r * D, a.in[17] + l * D, true, lane);
    }
    ss_t* ss = (ss_t*)(ws + WS_SS);
    for (int r0 = gw * 4; r0 < M; r0 += NGW * 4) {
        f32x4 v[4][4];
#pragma unroll
        for (int q = 0; q < 4; ++q)
#pragma unroll
            for (int j = 0; j < 4; ++j) v[q][j] = __builtin_nontemporal_load(&((const f32x4*)(a.in[0] + (size_t)(r0 + q) * D))[lane + 64 * j]);
#pragma unroll
        for (int q = 0; q < 4; ++q) {
            float sq = 0.f; u32x2* o8 = (u32x2*)((bf16_t*)(ws + WS_HB) + (size_t)(r0 + q) * D) + lane;
#pragma unroll
            for (int j = 0; j < 4; ++j) { const f32x4 x = v[q][j]; sq += (x[0] * x[0] + x[1] * x[1]) + (x[2] * x[2] + x[3] * x[3]); o8[64 * j] = (u32x2){pk(x[0], x[1]), pk(x[2], x[3])}; }
            sq = wave_sum(sq);
            if (lane < 9) ss[(size_t)lane * M + r0 + q] = lane == 0 ? ssfix(sq) : (ss_t)0;
        }
    }
}

__device__ __forceinline__ void conv_tile(LAS unsigned char* lds, const bf16_t* Z, bf16_t* MIX, const float* cw, const float* cb, const float* lng, const float* lnb, int tile, int wv) {
    const int tid = opaque_tid(wv), lane = tid & 63, wave = tid >> 6;
    const int tok0 = tile * 32, tseq = tok0 & (SEQ - 1);
    LAS float* Y = (LAS float*)(lds + 63488);
#pragma unroll 4
    for (int id = tid; id < 62 * 64; id += NTHREADS) {
        const int j = id >> 6, c8 = id & 63; u32x4 o = (u32x4){0u, 0u, 0u, 0u};
        if (tseq - 30 + j >= 0) o = *(const u32x4*)(Z + (size_t)(tok0 - 30 + j) * ZE_LD + c8 * 8);
        *(LAS u32x4*)(lds + j * 1024 + c8 * 16) = o;
    }
    __syncthreads();
    {
        const int c = tid; float w[31];
#pragma unroll
        for (int k = 0; k < 31; ++k) w[k] = cw[k * 512 + c];
        const float bias = cb[c];
#pragma unroll 1
        for (int tg = 0; tg < 4; ++tg) {
            float av[38];
#pragma unroll
            for (int j = 0; j < 38; ++j) av[j] = __builtin_bit_cast(float, (unsigned)(*(const LAS unsigned short*)(lds + (tg * 8 + j) * 1024 + c * 2)) << 16);
#pragma unroll
            for (int t = 0; t < 8; ++t) { float y = bias;
#pragma unroll
                for (int k = 0; k < 31; ++k) y += w[k] * av[t + k];
                Y[(tg * 8 + t) * 512 + c] = y; }
            asm volatile("" ::: "memory");
        }
    }
    __syncthreads();
    {
        const f32x4 g0 = *(const f32x4*)(lng + lane * 8), g1 = *(const f32x4*)(lng + lane * 8 + 4), b0 = *(const f32x4*)(lnb + lane * 8), b1 = *(const f32x4*)(lnb + lane * 8 + 4);
#pragma unroll 1
        for (int tt = 0; tt < 4; ++tt) {
            const int t = wave * 4 + tt;
            f32x4 v0 = *(const LAS f32x4*)(Y + t * 512 + lane * 8), v1 = *(const LAS f32x4*)(Y + t * 512 + lane * 8 + 4);
            const float mean = wave_sum((v0[0] + v0[1]) + (v0[2] + v0[3]) + (v1[0] + v1[1]) + (v1[2] + v1[3])) * (1.0f / 512.0f);
            v0 = v0 - mean; v1 = v1 - mean;
            const float var = wave_sum((v0[0] * v0[0] + v0[1] * v0[1]) + (v0[2] * v0[2] + v0[3] * v0[3]) + (v1[0] * v1[0] + v1[1] * v1[1]) + (v1[2] * v1[2] + v1[3] * v1[3])) * (1.0f / 512.0f);
            const float rstd = __builtin_amdgcn_rsqf(var + LN_EPS);
            f32x4 y0 = v0 * rstd * g0 + b0, y1 = v1 * rstd * g1 + b1;
#pragma unroll
            for (int e = 0; e < 4; ++e) { y0[e] = y0[e] * sigmoidf_(y0[e]); y1[e] = y1[e] * sigmoidf_(y1[e]); }
            u32x4 o; o.x = pk(y0[0], y0[1]); o.y = pk(y0[2], y0[3]); o.z = pk(y1[0], y1[1]); o.w = pk(y1[2], y1[3]);
            *(u32x4*)(MIX + (size_t)(tok0 + t) * D + lane * 8) = o;
        }
    }
    __syncthreads();
}

constexpr int KSTR = 144, VT_OFF = 36864, VSTR = 528;
__device__ __forceinline__ void swa_unit(LAS unsigned char* lds, const bf16_t* Z, bf16_t* MIX, const float* sinks, int unit, int wv) {
    const int tid = opaque_tid(wv), lane = tid & 63, wave = tid >> 6, hi = lane >> 5, l32 = lane & 31;
    const int kh = unit & 1, n = (unit >> 1) & 63, b = unit >> 7;
    const int tok0 = b * SEQ + n * 128;
    for (int id = tid; id < 2048; id += NTHREADS) {
        const int key = id >> 3, c = id & 7; u32x4 v = (u32x4){0u, 0u, 0u, 0u};
        if (n > 0 || key >= 128) v = *(const u32x4*)(Z + (size_t)(tok0 - 128 + key) * ZE_LD + 1024 + kh * 64 + c * 8);
        *(LAS u32x4*)(lds + key * KSTR + c * 16) = v;
    }
    {
        const int key = tid & 255, half = tid >> 8; u32x4 v[4];
#pragma unroll
        for (int c = 0; c < 4; ++c) { v[c] = (u32x4){0u, 0u, 0u, 0u}; if (n > 0 || key >= 128) v[c] = *(const u32x4*)(Z + (size_t)(tok0 - 128 + key) * ZE_LD + 1152 + kh * 64 + half * 32 + c * 8); }
        const int kap = key & 31, pos = (key & ~31) + 16 * (kap >> 4) + 8 * ((kap >> 2) & 1) + 4 * ((kap >> 3) & 1) + (kap & 3);
#pragma unroll
        for (int c = 0; c < 4; ++c)
#pragma unroll
            for (int e = 0; e < 4; ++e) { const int d = half * 32 + c * 8 + e * 2;
                *(LAS unsigned short*)(lds + VT_OFF + d * VSTR + pos * 2) = (unsigned short)(v[c][e] & 0xffffu);
                *(LAS unsigned short*)(lds + VT_OFF + (d + 1) * VSTR + pos * 2) = (unsigned short)(v[c][e] >> 16); }
    }
    __syncthreads();
#pragma unroll 1
    for (int itk = 0; itk < 2; ++itk) {
        const int task = wave + 8 * itk, g = task & 3, jq = task >> 2;
        const int H = kh * 4 + g; const float slope = exp2f(-(float)(H + 1)), sink = sinks[H];
        const int qtok = tok0 + 32 * jq + l32;
        bf16x8 qf[4];
#pragma unroll
        for (int ds = 0; ds < 4; ++ds) qf[ds] = *(const bf16x8*)(Z + (size_t)qtok * ZE_LD + 512 + H * 64 + 16 * ds + 8 * hi);
        f32x16 s[5];
#pragma unroll
        for (int tt = 0; tt < 5; ++tt) {
            s[tt] = (f32x16){0.f, 0.f, 0.f, 0.f, 0.f, 0.f, 0.f, 0.f, 0.f, 0.f, 0.f, 0.f, 0.f, 0.f, 0.f, 0.f};
            const int kt = jq + tt;
            asm volatile("" ::: "memory");
#pragma unroll
            for (int ds = 0; ds < 4; ++ds) { const bf16x8 kf = *(const LAS bf16x8*)(lds + (32 * kt + l32) * KSTR + (16 * ds + 8 * hi) * 2);
                s[tt] = __builtin_amdgcn_mfma_f32_32x32x16_bf16(kf, qf[ds], s[tt], 0, 0, 0); }
        }
        float mx = sink;
        float fb = (float)(128 + l32 - 4 * hi), fk = (float)(32 * jq + 4 * hi) - (n > 0 ? 0.f : 128.f);
        asm volatile("" : "+v"(fb), "+v"(fk));
#pragma unroll
        for (int tt = 0; tt < 5; ++tt)
#pragma unroll
            for (int i = 0; i < 16; ++i) {
                const float cst = (float)(32 * tt + (i & 3) + 8 * (i >> 2)); const float fd = fb - cst;
                const bool valid = fd >= 0.f && fd < 128.f && (fk + cst) >= 0.f;
                const float v = valid ? s[tt][i] * 0.125f - slope * fd : -INFINITY;
                s[tt][i] = v; mx = fmaxf(mx, v);
            }
        mx = fmaxf(mx, __shfl_xor(mx, 32));
        float sum = 0.f;
#pragma unroll
        for (int tt = 0; tt < 5; ++tt)
#pragma unroll
            for (int i = 0; i < 16; ++i) { const float p = __expf(s[tt][i] - mx); s[tt][i] = p; sum += p; }
        sum += __shfl_xor(sum, 32);
        sum += __expf(sink - mx);
        const float inv = 1.0f / sum;
        f32x16 o[2];
        o[0] = (f32x16){0.f, 0.f, 0.f, 0.f, 0.f, 0.f, 0.f, 0.f, 0.f, 0.f, 0.f, 0.f, 0.f, 0.f, 0.f, 0.f}; o[1] = o[0];
        asm volatile("" ::: "memory"); __builtin_amdgcn_sched_barrier(0);
#pragma unroll
        for (int tt = 0; tt < 5; ++tt) {
            const int kt = jq + tt;
            asm volatile("" ::: "memory"); __builtin_amdgcn_sched_barrier(0);
#pragma unroll
            for (int j = 0; j < 2; ++j) {
                u32x4 pw; pw.x = pk(s[tt][8 * j + 0], s[tt][8 * j + 1]); pw.y = pk(s[tt][8 * j + 2], s[tt][8 * j + 3]); pw.z = pk(s[tt][8 * j + 4], s[tt][8 * j + 5]); pw.w = pk(s[tt][8 * j + 6], s[tt][8 * j + 7]);
                const bf16x8 pb = __builtin_bit_cast(bf16x8, pw);
#pragma unroll
                for (int dt = 0; dt < 2; ++dt) { const bf16x8 vf = *(const LAS bf16x8*)(lds + VT_OFF + (32 * dt + l32) * VSTR + (32 * kt + 16 * j + 8 * hi) * 2);
                    o[dt] = __builtin_amdgcn_mfma_f32_32x32x16_bf16(vf, pb, o[dt], 0, 0, 0); }
            }
        }
        bf16_t* orow = MIX + (size_t)qtok * D + 512 + H * 64;
#pragma unroll
        for (int dt = 0; dt < 2; ++dt)
#pragma unroll
            for (int q4 = 0; q4 < 4; ++q4) { const int d = 32 * dt + 8 * q4 + 4 * hi;
                *(u32x2*)(orow + d) = (u32x2){pk(o[dt][4 * q4] * inv, o[dt][4 * q4 + 1] * inv), pk(o[dt][4 * q4 + 2] * inv, o[dt][4 * q4 + 3] * inv)}; }
    }
    __syncthreads();
}

__device__ __forceinline__ void sc_unit(const bf16_t* Z, bf16_t* MIX, const float* w, int unit, int wv) {
    const int tid = opaque_tid(wv), cc = tid & 127, tg = tid >> 7;
    const int tok0 = unit * 64 + tg * 16, tseq = tok0 & (SEQ - 1), c = cc * 8;
    float w0[8], w1[8], w2[8], p2[8], p1[8];
#pragma unroll
    for (int e = 0; e < 8; ++e) { w0[e] = w[c + e]; w1[e] = w[1024 + c + e]; w2[e] = w[2048 + c + e]; p2[e] = 0.f; p1[e] = 0.f; }
    if (tseq > 0) {
#pragma unroll
        for (int back = 2; back >= 1; --back) {
            const u32x4 gv = *(const u32x4*)(Z + (size_t)(tok0 - back) * ZO_LD + 1024 + c);
#pragma unroll
            for (int e = 0; e < 4; ++e) { if (back == 2) { p2[2 * e] = bflo(gv[e]); p2[2 * e + 1] = bfhi(gv[e]); } else { p1[2 * e] = bflo(gv[e]); p1[2 * e + 1] = bfhi(gv[e]); } }
        }
    }
#pragma unroll 1
    for (int t4 = 0; t4 < 16; t4 += 8) {
    asm volatile("" ::: "memory");
#pragma unroll
    for (int t = t4; t < t4 + 8; ++t) {
        const bf16_t* p = Z + (size_t)(tok0 + t) * ZO_LD + c; const u32x4 gb = *(const u32x4*)p, gv = *(const u32x4*)(p + 1024);
        float cur[8], y[8];
#pragma unroll
        for (int e = 0; e < 4; ++e) { cur[2 * e] = bflo(gv[e]); cur[2 * e + 1] = bfhi(gv[e]); }
#pragma unroll
        for (int e = 0; e < 8; ++e) { const float gbv = (e & 1) ? bfhi(gb[e >> 1]) : bflo(gb[e >> 1]); y[e] = gbv * (w0[e] * p2[e] + w1[e] * p1[e] + w2[e] * cur[e]); p2[e] = p1[e]; p1[e] = cur[e]; }
        u32x4 o; o.x = pk(y[0], y[1]); o.y = pk(y[2], y[3]); o.z = pk(y[4], y[5]); o.w = pk(y[6], y[7]);
        *(u32x4*)(MIX + (size_t)(tok0 + t) * D + c) = o;
    }
    }
}

#ifndef PROBE_MASK
#define PROBE_MASK 0u
#endif
#define NREP(kind) ((((PROBE_MASK) >> (kind)) & 1u) ? 2 : 1)
constexpr int N_PHASES = 19;
__global__ void __launch_bounds__(NTHREADS, 2) fwd_mega(Args a) {
    extern __shared__ __attribute__((aligned(16))) unsigned char lds_raw[];
    LAS unsigned char* lds = (LAS unsigned char*)lds_raw;
    LAS unsigned char* ex = lds + EXCH_OFF;
    cg::grid_group grid = cg::this_grid();
    int G = gridDim.x, bx = blockIdx.x;
    int wv = __builtin_amdgcn_readfirstlane((int)threadIdx.x >> 6);
    unsigned char* ws = a.ws;
    __attribute__((address_space(1))) unsigned char* wsg = (__attribute__((address_space(1))) unsigned char*)a.ws;
#define OPQ() do { asm volatile("" : "+s"(wsg), "+s"(G), "+s"(bx), "+s"(wv)); ws = (unsigned char*)wsg; } while (0)
#define SS ((ss_t*)(ws + WS_SS))
#define HB ((bf16_t*)(ws + WS_HB))
#define MIX ((bf16_t*)(ws + WS_MIX))
#define ZH ((bf16_t*)(ws + WS_ZH))
    float* OUT = a.out;
    const int lo = a.ph_lo, hi = a.ph_hi;
#ifndef PH_MASK
#define PH_MASK 0xffffffffu
#endif
#define IN(k) (((PH_MASK >> (k)) & 1u) && lo <= (k) && (k) < hi)
#define SEAM0() do { if (IN(0) && IN(1)) { xcd_barrier(xb); } } while (0)
#define SEAM(k) do { if (IN(k) && IN((k) + 1)) { xcd_barrier(xb); } } while (0)
    if (threadIdx.x < 4) ((LAS unsigned*)(lds + BARST_OFF))[threadIdx.x] = 0u;
    __syncthreads();
    XcdBarrier xb; xb.bar = (unsigned*)(ws + WS_BAR); xb.x = 0; xb.st = (volatile LAS unsigned*)(lds + BARST_OFF);
    if (lo == 0 && hi > 1) xb = xcd_barrier_post((unsigned*)(ws + WS_BAR), (volatile LAS unsigned*)(lds + BARST_OFF));
    if (hi < 0) grid.sync();
    if (threadIdx.x == 0) { const unsigned xcc = xb_xcc_id(); const unsigned rk = atomicAdd((unsigned*)(ws + WS_CEN) + (xcc & 7u) * 16u, 1u); ((LAS unsigned*)(lds + BARST_OFF))[2] = xcc; ((LAS unsigned*)(lds + BARST_OFF))[3] = rk; }
    __syncthreads();
    if (IN(0)) { for (int rep = 0; rep < NREP(10); ++rep) p0_prologue(a, lds, G, wv); }
    SEAM0();
    if (lo == 0 && hi > 1) {
        bool even = true;
        for (int j = 0; j < 8; ++j) even = even && (__hip_atomic_load((unsigned*)(ws + WS_CEN) + j * 16, __ATOMIC_RELAXED, __HIP_MEMORY_SCOPE_AGENT) * 8u == (unsigned)G);
        const unsigned xcc = ((volatile LAS unsigned*)(lds + BARST_OFF))[2], rk = ((volatile LAS unsigned*)(lds + BARST_OFF))[3];
        if (even && (G % 8) == 0 && xcc < 8u) bx = (int)(rk * 8u + xcc);
        bx = __builtin_amdgcn_readfirstlane(bx);
    }
#pragma unroll 1
    for (int l = 0; l < 2; ++l) {
        const int pb = 1 + l * 9;
        if (IN(pb + 0)) { OPQ();
            pg8::Gemm g{HB, (const bf16_t*)(ws + WS_WGU) + (size_t)(2 * l) * 2 * F * D, D, D, D}; pg8::StdOrder S; S.init(M, 2 * F, G, bx, D, D);
            pg8::EpiSwiGLU E{ZH, SS + (size_t)(4 * l) * M}; if (NREP(0) > 1) { pg8::EpiNull EN; pg8::gemm_phase(lds, ex, g, S, EN, wv); } pg8::gemm_phase<pg8::EpiSwiGLU, pg8::StdOrder, false, true>(lds, ex, g, S, E, wv);
        }
        SEAM(pb + 0);
        if (IN(pb + 1)) { OPQ();
            pg8::Gemm g{ZH, (const bf16_t*)(ws + WS_WDN) + (size_t)(2 * l) * F * D, F, F, F}; pg8::StdOrder S; S.init(M, D, G, bx, F, F);
            { pg8::EpiRes<false> E{nullptr, HB, SS + (size_t)(4 * l + 1) * M, 0.5f, nullptr}; pg8::gemm_phase(lds, ex, g, S, E, wv); }
        }
        SEAM(pb + 1);
        if (IN(pb + 2)) { OPQ();
            if (l == 0) { { pg8::Gemm g{HB, (const bf16_t*)(ws + WS_WEIN), D, D, D}; pg8::StdOrder S; S.init(M, EIN, G, bx, D, D);
                pg8::EpiGate<0> E{ZH, ZE_LD, SS + (size_t)(4 * l + 1) * M}; for (int rep = 0; rep < NREP(2); ++rep) pg8::gemm_phase(lds, ex, g, S, E, wv); }
                { pg8::Gemm g{(const bf16_t*)(ws + WS_MEMN), (const bf16_t*)(ws + WS_WKV), D, D, D}; pg8::StdOrder S; S.init(2048, 2048, G, (bx + G / 2) % G, D, D, 2, 2048);
                  pg8::EpiBf16<false> E{(bf16_t*)(ws + WS_KV), 2048, nullptr, 1.0f}; pg8::gemm_phase(lds, ex, g, S, E, wv); } }
            else { pg8::Gemm g{HB, (const bf16_t*)(ws + WS_WOIN), D, D, D}; pg8::StdOrder S; S.init(M, OIN, G, bx, D, D);
                pg8::EpiGate<1> E{ZH, ZO_LD, SS + (size_t)(4 * l + 1) * M}; for (int rep = 0; rep < NREP(2); ++rep) pg8::gemm_phase(lds, ex, g, S, E, wv); }
        }
        SEAM(pb + 2);
        if (IN(pb + 3)) { OPQ();
            for (int rep = 0; rep < NREP(3); ++rep)
            if (l == 0) {
                for (int t = bx; t < M / 32; t += G) conv_tile(lds, ZH, MIX, a.in[7], a.in[8], a.in[9], a.in[10], t, wv);
                for (int u = bx; u < NB * 64 * 2; u += G) swa_unit(lds, ZH, MIX, a.in[11], u, wv);
                const int kfold = 256 + (lo >> 8);
                { pg8::Gemm g{(const bf16_t*)(ws + WS_KV), (const bf16_t*)(ws + WS_WQ), 2048, D, kfold}; pg8::FoldSOrder S{G, bx};
                  pg8::EpiFp8 E{ws + WS_WST, D, 1.0f}; pg8::gemm_phase(lds, ex, g, S, E, wv); }
                { pg8::Gemm g{(const bf16_t*)(ws + WS_WOT), (const bf16_t*)(ws + WS_KV), D, 2048, kfold}; pg8::FoldVOrder S{G, (bx + 128) % G};
                  pg8::EpiFp8 E{ws + WS_WVOT, D, 1.0f}; pg8::gemm_phase(lds, ex, g, S, E, wv); }
            } else {
                for (int u = bx; u < M / 64; u += G) sc_unit(ZH, MIX, a.in[14], u, wv);
            }
        }
        SEAM(pb + 3);
        if (IN(pb + 4)) { OPQ();
            pg8::Gemm g{MIX, (const bf16_t*)(ws + (l == 0 ? WS_WEOUT : WS_WOOUT)), D, D, D}; pg8::StdOrder S; S.init(M, D, G, bx, D, D);
            pg8::EpiRes<false, true> E{nullptr, HB, SS + (size_t)(4 * l + 2) * M, 1.0f, ws + WS_HB8}; pg8::gemm_phase(lds, ex, g, S, E, wv);
        }
        SEAM(pb + 4);
        if (IN(pb + 5)) { OPQ();
            pg8::Gemm g{(const bf16_t*)(ws + WS_HB8), (const bf16_t*)(ws + WS_WST + (size_t)l * 4 * D * D), D / 2, D / 2, D / 2}; pg8::StdOrder S; S.init(M, D, G, bx, D / 2, D / 2, 5, 1024);
            pg8::EpiSoftmax<true> E{MIX, SS + (size_t)(4 * l + 2) * M}; for (int rep = 0; rep < NREP(5); ++rep) pg8::gemm_phase<pg8::EpiSoftmax<true>, pg8::StdOrder, true>(lds, ex, g, S, E, wv);
        }
        SEAM(pb + 5);
        if (IN(pb + 6)) { OPQ();
            pg8::Gemm g{MIX, (const bf16_t*)(ws + WS_WVOT + (size_t)l * 4 * D * D), D / 2, D / 2, D / 2}; pg8::StdOrder S; S.init(M, D, G, bx, D / 2, D / 2, 5, 1024);
            pg8::EpiRes<false> E{nullptr, HB, SS + (size_t)(4 * l + 3) * M, 1.0f / 256.0f, nullptr}; pg8::gemm_phase<pg8::EpiRes<false>, pg8::StdOrder, true>(lds, ex, g, S, E, wv);
        }
        SEAM(pb + 6);
        if (IN(pb + 7)) { OPQ();
            pg8::Gemm g{HB, (const bf16_t*)(ws + WS_WGU) + (size_t)(2 * l + 1) * 2 * F * D, D, D, D}; pg8::StdOrder S; S.init(M, 2 * F, G, bx, D, D);
            pg8::EpiSwiGLU E{ZH, SS + (size_t)(4 * l + 3) * M}; if (NREP(7) > 1) { pg8::EpiNull EN; pg8::gemm_phase(lds, ex, g, S, EN, wv); } pg8::gemm_phase<pg8::EpiSwiGLU, pg8::StdOrder, false, true>(lds, ex, g, S, E, wv);
        }
        SEAM(pb + 7);
        if (IN(pb + 8)) { OPQ();
            pg8::Gemm g{ZH, (const bf16_t*)(ws + WS_WDN) + (size_t)(2 * l + 1) * F * D, F, F, F}; pg8::StdOrder S; S.init(M, D, G, bx, F, F);
            if (l == 0) { pg8::EpiRes<false> E{nullptr, HB, SS + (size_t)(4 * l + 4) * M, 0.5f, nullptr}; pg8::gemm_phase(lds, ex, g, S, E, wv); }
            else { pg8::EpiResFinal E{HB, SS + (size_t)8 * M, (unsigned*)(ws + WS_PCNT), a.in[24], OUT, 0.5f}; pg8::gemm_phase(lds, ex, g, S, E, wv); }
        }
        SEAM(pb + 8);
    }
#undef IN
#undef SEAM
#undef SEAM0
#undef OPQ
#undef SS
#undef HB
#undef MIX
#undef ZH
}

#ifndef N_LAUNCH_MODE
#define N_LAUNCH_MODE 0
#endif
extern "C" void kernel_launch(void* const* d_in, const int* in_sizes, int n_in, void* d_out, int out_size, void* d_ws, size_t ws_size, hipStream_t stream) {
    static int grid = 0;
    if (grid == 0) {
        int dev = 0, cus = 0, per_cu = 0;
        hipGetDevice(&dev); hipDeviceGetAttribute(&cus, hipDeviceAttributeMultiprocessorCount, dev);
        if (hipFuncSetAttribute((const void*)fwd_mega, hipFuncAttributeMaxDynamicSharedMemorySize, LDS_BYTES) != hipSuccess) { fprintf(stderr, "hipFuncSetAttribute failed\n"); grid = -1; return; }
        if (hipOccupancyMaxActiveBlocksPerMultiprocessor(&per_cu, (const void*)fwd_mega, NTHREADS, LDS_BYTES) != hipSuccess || per_cu < 1) { fprintf(stderr, "occupancy query: %d\n", per_cu); per_cu = 1; }
        (void)hipGetLastError();
        grid = cus * 1;
        if (n_in != 25 || ws_size < WS_END) { fprintf(stderr, "kernel_launch: unexpected n_in %d / ws %zu\n", n_in, ws_size); grid = -1; return; }
    }
    if (grid < 0) return;
    if (hipMemsetAsync((char*)d_ws + WS_BAR, 0, WS_PCNT + 128 * 256 - WS_BAR, stream) != hipSuccess) { fprintf(stderr, "kernel_launch: hipMemsetAsync failed\n"); return; }
    Args a{};
    for (int i = 0; i < 25; ++i) a.in[i] = (const float*)d_in[i];
    a.out = (float*)d_out; a.ws = (unsigned char*)d_ws;
#if N_LAUNCH_MODE == 0
    a.ph_lo = 0; a.ph_hi = N_PHASES;
    { void* args[] = {&a}; hipError_t e = hipLaunchCooperativeKernel((const void*)fwd_mega, dim3(grid), dim3(NTHREADS), args, LDS_BYTES, stream);
      if (e != hipSuccess) fprintf(stderr, "cooperative launch failed: %s (grid %d)\n", hipGetErrorString(e), grid); }
#else
    for (int p = 0; p < N_PHASES; ++p) {
        a.ph_lo = p; a.ph_hi = p + 1; void* args[] = {&a};
        hipError_t e = hipLaunchCooperativeKernel((const void*)fwd_mega, dim3(grid), dim3(NTHREADS), args, LDS_BYTES, stream);
        if (e != hipSuccess) { fprintf(stderr, "cooperative launch %d failed: %s (grid %d)\n", p, hipGetErrorString(e), grid); break; }
    }
#endif
}
```
